# Optimizing an MI355X kernel written in HIP

```python
import math
import jax, jax.numpy as jnp
from jax import lax
import numpy as np

D_MODEL = 1024
BATCH = 2
SEQ = 8192
DEPTH = 2
DEC_BATCH = 32
DEC_SEQ = 8
PAST_LEN = 16384
PAGE_SIZE = 128

N_AB_LAYERS = (DEPTH + 1) // 2
N_C_LAYERS = DEPTH // 2

H_A = 4
DK_A = 64
DV_A = 128
RET_CHUNK = 128
H_B = 8
DH_B = 64
SWA_PAIRS = ((128, 1), (512, 4), (2048, 16))
SWA_MAX_WINDOW = 2048
S5_GROUP = 16
S5_GROUPS = D_MODEL // S5_GROUP
S5_STATE = 64
D_FF = -(-8 * D_MODEL // (3 * 256)) * 256

AB_WIDTHS = (H_A * DK_A, H_A * DK_A, H_A * DV_A, H_A * DV_A, H_B * DH_B, H_B * DH_B, H_B * DH_B)
AB_IN_WIDTH = sum(AB_WIDTHS)
AB_SPLITS = tuple(int(c) for c in np.cumsum(AB_WIDTHS)[:-1])
AB_MIX_WIDTH = H_A * DV_A + H_B * DH_B

EPS = 1e-6
NEG_INF = -1e30

kernel_name = "retnet_longnet_s5_hybrid_step"


def rms_norm(x, g):
    xf = x.astype(jnp.float32)
    y = xf * lax.rsqrt(jnp.mean(xf * xf, axis=-1, keepdims=True) + EPS)
    return (y * g.astype(jnp.float32)).astype(x.dtype)


def swiglu(h, w_in, w_out):
    gate, up = jnp.split(h @ w_in, 2, axis=-1)
    return (jax.nn.silu(gate) * up) @ w_out


def swa_buffer_len():
    return min(SWA_MAX_WINDOW, PAST_LEN)


def alibi_slopes():
    return jnp.exp2(-8.0 * jnp.arange(1, H_B + 1, dtype=jnp.float32) / H_B)


def retention_log_decay():
    return jnp.log1p(-jnp.exp2(-5.0 - jnp.arange(H_A, dtype=jnp.float32)))


def window_rows(x, n):
    seq = x.shape[1]
    if seq >= n:
        return x[:, seq - n:]
    return jnp.pad(x, ((0, 0), (n - seq, 0), (0, 0), (0, 0)))


def retention_chunk(q, k, v, state, log_g):
    c = q.shape[1]
    idx = jnp.arange(c, dtype=jnp.float32)
    rel = idx[:, None] - idx[None, :]
    decay = jnp.where(rel >= 0, jnp.exp(jnp.maximum(rel, 0.0)[None] * log_g[:, None, None]), 0.0)
    scores = jnp.einsum('bnhd,bmhd->bhnm', q, k) * decay[None]
    inner = jnp.einsum('bhnm,bmhe->bnhe', scores, v)
    q_decay = jnp.exp((idx + 1.0)[:, None] * log_g[None, :])
    cross = jnp.einsum('bnhd,bhde->bnhe', q, state) * q_decay[None, :, :, None]
    k_decay = jnp.exp((c - 1.0 - idx)[:, None] * log_g[None, :])
    new_state = (jnp.exp(c * log_g)[None, :, None, None] * state
                 + jnp.einsum('bmhd,bmhe->bhde', k * k_decay[None, :, :, None], v))
    return inner + cross, new_state


def retention(q, k, v, state, chunk):
    bsz, seq, nh, dk = q.shape
    n_chunks = seq // chunk
    log_g = retention_log_decay()

    def to_chunks(x):
        return jnp.swapaxes(x.astype(jnp.float32).reshape(bsz, n_chunks, chunk, nh, x.shape[-1]), 0, 1)

    def step(st, qkv):
        o, st = retention_chunk(qkv[0], qkv[1], qkv[2], st, log_g)
        return st, o

    state, o = lax.scan(step, state.astype(jnp.float32),
                        (to_chunks(q), to_chunks(k) * dk ** -0.5, to_chunks(v)))
    return jnp.swapaxes(o, 0, 1).reshape(bsz, seq, nh, -1), state


def head_group_norm(o, gain):
    mu = jnp.mean(o, axis=-1, keepdims=True)
    var = jnp.mean(jnp.square(o - mu), axis=-1, keepdims=True)
    y = (o - mu) * lax.rsqrt(var + EPS)
    return y.reshape(o.shape[0], o.shape[1], -1) * gain.astype(jnp.float32)


def dilated_branch_prompt(q, k, v, window, dil, slopes):
    bsz, seq, nh, dh = q.shape
    span = window // dil
    sub = seq // dil
    pad = (-sub) % span

    def blocks(x):
        x = x.reshape(bsz, sub, dil, nh, dh).transpose(0, 2, 1, 3, 4)
        x = jnp.pad(x, ((0, 0), (0, 0), (0, pad), (0, 0), (0, 0)))
        return x.reshape(bsz, dil, -1, span, nh, dh)

    qb, kb, vb = blocks(q), blocks(k), blocks(v)
    nblk = qb.shape[2]

    def with_prev(x):
        prev = jnp.pad(x[:, :, :-1], ((0, 0), (0, 0), (1, 0), (0, 0), (0, 0), (0, 0)))
        return jnp.concatenate([prev, x], axis=3)

    kk, vv = with_prev(kb), with_prev(vb)
    qi = jnp.arange(span)[:, None]
    kj = jnp.arange(2 * span)[None, :]
    dist = span + qi - kj
    key_pos = (jnp.arange(nblk)[:, None, None] - 1) * span + kj[None]
    valid = (dist >= 0) & (dist <= span) & (key_pos >= 0)
    bias = -slopes[:, None, None] * (dil * dist).astype(jnp.float32)[None]
    s = jnp.einsum('brnqhd,brnkhd->brnhqk', qb, kk) * dh ** -0.5 + bias
    s = jnp.where(valid[:, None], s, NEG_INF)
    m = jnp.max(s, axis=-1, keepdims=True)
    p = jnp.exp(s - m)
    den = jnp.sum(p, axis=-1, keepdims=True)
    o = jnp.einsum('brnhqk,brnkhd->brnqhd', p / den, vv)
    lse = (m + jnp.log(den))[..., 0].transpose(0, 1, 2, 4, 3)

    def unblock(x):
        x = x.reshape((bsz, dil, nblk * span) + x.shape[4:])[:, :, :sub]
        x = jnp.swapaxes(x, 1, 2)
        return x.reshape((bsz, seq) + x.shape[3:])

    return unblock(o), unblock(lse)


def dilated_branch_sample(q, k_all, v_all, window, dil, slopes, p0):
    n_new, dh = q.shape[1], q.shape[-1]
    steps = jnp.arange(window // dil + 1)
    pos = PAST_LEN + jnp.arange(n_new)[:, None] - dil * steps[None, :]
    valid = pos >= 0
    idx = jnp.clip(pos - p0, 0, k_all.shape[1] - 1)
    kg = k_all[:, idx]
    vg = v_all[:, idx]
    bias = -slopes[:, None] * (dil * steps).astype(jnp.float32)[None, :]
    s = jnp.einsum('bthd,btkhd->bthk', q, kg) * dh ** -0.5 + bias
    s = jnp.where(valid[:, None, :], s, NEG_INF)
    m = jnp.max(s, axis=-1, keepdims=True)
    p = jnp.exp(s - m)
    den = jnp.sum(p, axis=-1, keepdims=True)
    o = jnp.einsum('bthk,btkhd->bthd', p / den, vg)
    return o, (m + jnp.log(den))[..., 0]


def merge_dilation_branches(branches):
    outs = jnp.stack([o for o, _ in branches])
    lses = jnp.stack([l for _, l in branches])
    wts = jax.nn.softmax(lses, axis=0)
    return jnp.einsum('gbsh,gbshd->bshd', wts, outs)


def ab_project(h, w_in):
    bsz, seq, _ = h.shape
    q_a, k_a, v_a, g_a, q_b, k_b, v_b = jnp.split(h @ w_in, AB_SPLITS, axis=-1)
    hd = lambda t, n: t.reshape(bsz, seq, n, -1)
    return (hd(q_a, H_A), hd(k_a, H_A), hd(v_a, H_A), g_a,
            hd(q_b, H_B), hd(k_b, H_B), hd(v_b, H_B))


def ab_merge(h, o_a, g_a, o_b, gn_gain, w_out):
    bsz, seq, _ = h.shape
    a = jax.nn.silu(g_a.astype(jnp.float32)) * head_group_norm(o_a, gn_gain)
    mixed = jnp.concatenate([a, o_b.reshape(bsz, seq, -1)], axis=-1)
    return mixed.astype(h.dtype) @ w_out


def ab_mixer_prompt(h, w_in, gn_gain, w_out, ret_state0):
    q_a, k_a, v_a, g_a, q_b, k_b, v_b = ab_project(h, w_in)
    o_a, ret_state = retention(q_a, k_a, v_a, ret_state0, RET_CHUNK)
    slopes = alibi_slopes()
    qf, kf, vf = q_b.astype(jnp.float32), k_b.astype(jnp.float32), v_b.astype(jnp.float32)
    o_b = merge_dilation_branches([dilated_branch_prompt(qf, kf, vf, w, d, slopes) for (w, d) in SWA_PAIRS])
    out = ab_merge(h, o_a, g_a, o_b, gn_gain, w_out)
    buf = swa_buffer_len()
    return out, ret_state, window_rows(k_b, buf), window_rows(v_b, buf)


def ab_mixer_sample(h, w_in, gn_gain, w_out, ret_state0, k_past, v_past):
    q_a, k_a, v_a, g_a, q_b, k_b, v_b = ab_project(h, w_in)
    o_a, ret_state = retention(q_a, k_a, v_a, ret_state0, q_a.shape[1])
    k_all = jnp.concatenate([k_past.astype(k_b.dtype), k_b], axis=1)
    v_all = jnp.concatenate([v_past.astype(v_b.dtype), v_b], axis=1)
    buf = k_past.shape[1]
    p0 = PAST_LEN - buf
    slopes = alibi_slopes()
    qf, kf, vf = q_b.astype(jnp.float32), k_all.astype(jnp.float32), v_all.astype(jnp.float32)
    o_b = merge_dilation_branches([dilated_branch_sample(qf, kf, vf, w, d, slopes, p0) for (w, d) in SWA_PAIRS])
    out = ab_merge(h, o_a, g_a, o_b, gn_gain, w_out)
    return out, ret_state, k_all[:, -buf:], v_all[:, -buf:]


def complex_affine_combine(e1, e2):
    a1r, a1i, b1r, b1i = e1
    a2r, a2i, b2r, b2i = e2
    return (a1r * a2r - a1i * a2i, a1r * a2i + a1i * a2r,
            a2r * b1r - a2i * b1i + b2r, a2r * b1i + a2i * b1r + b2i)


def s5_mixer(h, lam_re, lam_im, log_step, b_re, b_im, c_re, c_im, d_skip, w_glu, x0_re, x0_im):
    bsz, seq, _ = h.shape
    f32 = jnp.float32
    lam_re, lam_im = lam_re.astype(f32), lam_im.astype(f32)
    dt = jnp.exp(log_step.astype(f32))[:, None]
    mag = jnp.exp(lam_re * dt)
    ab_re, ab_im = mag * jnp.cos(lam_im * dt), mag * jnp.sin(lam_im * dt)
    den = lam_re * lam_re + lam_im * lam_im
    f_re = ((ab_re - 1.0) * lam_re + ab_im * lam_im) / den
    f_im = (ab_im * lam_re - (ab_re - 1.0) * lam_im) / den
    u = h.astype(f32).reshape(bsz, seq, S5_GROUPS, S5_GROUP)
    bu_re = jnp.einsum('bsgp,gnp->bsgn', u, b_re.astype(f32))
    bu_im = jnp.einsum('bsgp,gnp->bsgn', u, b_im.astype(f32))
    drive_re = f_re * bu_re - f_im * bu_im
    drive_im = f_re * bu_im + f_im * bu_re
    x0_re, x0_im = x0_re.astype(f32), x0_im.astype(f32)
    drive_re = drive_re.at[:, 0].add(ab_re * x0_re - ab_im * x0_im)
    drive_im = drive_im.at[:, 0].add(ab_re * x0_im + ab_im * x0_re)
    a_re = jnp.broadcast_to(ab_re, (1, seq) + ab_re.shape)
    a_im = jnp.broadcast_to(ab_im, (1, seq) + ab_im.shape)
    _, _, xs_re, xs_im = lax.associative_scan(complex_affine_combine, (a_re, a_im, drive_re, drive_im), axis=1)
    y = (jnp.einsum('bsgn,gpn->bsgp', xs_re, c_re.astype(f32))
         - jnp.einsum('bsgn,gpn->bsgp', xs_im, c_im.astype(f32))
         + d_skip.astype(f32).reshape(S5_GROUPS, S5_GROUP) * u).reshape(bsz, seq, D_MODEL)
    z = jax.nn.gelu(y).astype(h.dtype)
    val, gate = jnp.split(z @ w_glu, 2, axis=-1)
    return val * jax.nn.sigmoid(gate), xs_re[:, -1], xs_im[:, -1]


def setup_inputs(seed: int = 0) -> dict:
    key = jax.random.key(seed)
    ks = jax.random.split(key, 24)
    f32 = jnp.float32
    nrm = lambda k, shape, scale: scale * jax.random.normal(k, shape, f32)
    buf = swa_buffer_len()
    n_idx = jnp.arange(S5_STATE, dtype=f32)
    ssm_shape = (N_C_LAYERS, S5_GROUPS, S5_STATE)
    return {
        'x_prompt': nrm(ks[0], (BATCH, SEQ, D_MODEL), 1.0),
        'x_sample': nrm(ks[1], (DEC_BATCH, DEC_SEQ, D_MODEL), 1.0),
        'state_ret': nrm(ks[2], (N_AB_LAYERS, DEC_BATCH, H_A, DK_A, DV_A), 1.0),
        'state_swa_k': nrm(ks[3], (N_AB_LAYERS, DEC_BATCH, buf, H_B, DH_B), 1.0),
        'state_swa_v': nrm(ks[4], (N_AB_LAYERS, DEC_BATCH, buf, H_B, DH_B), 1.0),
        'state_ssm_re': nrm(ks[5], (N_C_LAYERS, DEC_BATCH, S5_GROUPS, S5_STATE), 0.5),
        'state_ssm_im': nrm(ks[6], (N_C_LAYERS, DEC_BATCH, S5_GROUPS, S5_STATE), 0.5),
        'norm_mix': 1.0 + nrm(ks[7], (DEPTH, D_MODEL), 0.02),
        'norm_ffn': 1.0 + nrm(ks[8], (DEPTH, D_MODEL), 0.02),
        'norm_final': 1.0 + nrm(ks[9], (D_MODEL,), 0.02),
        'w_in_ab': nrm(ks[10], (N_AB_LAYERS, D_MODEL, AB_IN_WIDTH), D_MODEL ** -0.5),
        'ret_gn': 1.0 + nrm(ks[11], (N_AB_LAYERS, H_A * DV_A), 0.02),
        'w_out_ab': nrm(ks[12], (N_AB_LAYERS, AB_MIX_WIDTH, D_MODEL), AB_MIX_WIDTH ** -0.5),
        'ssm_lam_re': -0.5 + nrm(ks[13], ssm_shape, 0.01),
        'ssm_lam_im': math.pi * n_idx + nrm(ks[14], ssm_shape, 0.01),
        'ssm_log_step': jax.random.uniform(ks[15], (N_C_LAYERS, S5_GROUPS), f32, math.log(1e-3), math.log(1e-1)),
        'ssm_b_re': nrm(ks[16], (N_C_LAYERS, S5_GROUPS, S5_STATE, S5_GROUP), (2 * S5_GROUP) ** -0.5),
        'ssm_b_im': nrm(ks[17], (N_C_LAYERS, S5_GROUPS, S5_STATE, S5_GROUP), (2 * S5_GROUP) ** -0.5),
        'ssm_c_re': nrm(ks[18], (N_C_LAYERS, S5_GROUPS, S5_GROUP, S5_STATE), S5_STATE ** -0.5),
        'ssm_c_im': nrm(ks[19], (N_C_LAYERS, S5_GROUPS, S5_GROUP, S5_STATE), S5_STATE ** -0.5),
        'ssm_d': nrm(ks[20], (N_C_LAYERS, D_MODEL), 1.0),
        'w_glu': nrm(ks[21], (N_C_LAYERS, D_MODEL, 2 * D_MODEL), D_MODEL ** -0.5),
        'w_ffn_in': nrm(ks[22], (DEPTH, D_MODEL, 2 * D_FF), D_MODEL ** -0.5),
        'w_ffn_out': nrm(ks[23], (DEPTH, D_FF, D_MODEL), D_FF ** -0.5),
    }


def reference(x_prompt, x_sample, state_ret, state_swa_k, state_swa_v, state_ssm_re, state_ssm_im,
              norm_mix, norm_ffn, norm_final, w_in_ab, ret_gn, w_out_ab,
              ssm_lam_re, ssm_lam_im, ssm_log_step, ssm_b_re, ssm_b_im, ssm_c_re, ssm_c_im, ssm_d, w_glu,
              w_ffn_in, w_ffn_out):
    yp, ys = x_prompt, x_sample
    ret_p, ret_s = [], []
    swk_p, swv_p, swk_s, swv_s = [], [], [], []
    sr_p, si_p, sr_s, si_s = [], [], [], []
    for layer in range(DEPTH):
        i = layer // 2
        hp = rms_norm(yp, norm_mix[layer])
        hs = rms_norm(ys, norm_mix[layer])
        if layer % 2 == 0:
            zero_ret = jnp.zeros((yp.shape[0], H_A, DK_A, DV_A), jnp.float32)
            mp, r_p, k_p, v_p = ab_mixer_prompt(hp, w_in_ab[i], ret_gn[i], w_out_ab[i], zero_ret)
            ms, r_s, k_s, v_s = ab_mixer_sample(hs, w_in_ab[i], ret_gn[i], w_out_ab[i],
                                                state_ret[i], state_swa_k[i], state_swa_v[i])
            ret_p.append(r_p); ret_s.append(r_s)
            swk_p.append(k_p); swv_p.append(v_p); swk_s.append(k_s); swv_s.append(v_s)
        else:
            s5w = (ssm_lam_re[i], ssm_lam_im[i], ssm_log_step[i], ssm_b_re[i], ssm_b_im[i],
                   ssm_c_re[i], ssm_c_im[i], ssm_d[i], w_glu[i])
            zero_ssm = jnp.zeros((yp.shape[0], S5_GROUPS, S5_STATE), jnp.float32)
            mp, xr_p, xi_p = s5_mixer(hp, *s5w, zero_ssm, zero_ssm)
            ms, xr_s, xi_s = s5_mixer(hs, *s5w, state_ssm_re[i], state_ssm_im[i])
            sr_p.append(xr_p); si_p.append(xi_p); sr_s.append(xr_s); si_s.append(xi_s)
        yp = yp + mp
        ys = ys + ms
        yp = yp + swiglu(rms_norm(yp, norm_ffn[layer]), w_ffn_in[layer], w_ffn_out[layer])
        ys = ys + swiglu(rms_norm(ys, norm_ffn[layer]), w_ffn_in[layer], w_ffn_out[layer])
    yp = rms_norm(yp, norm_final)
    ys = rms_norm(ys, norm_final)
    return (yp, ys,
            jnp.stack(ret_p), jnp.stack(ret_s),
            jnp.stack(swk_p), jnp.stack(swv_p), jnp.stack(swk_s), jnp.stack(swv_s),
            jnp.stack(sr_p), jnp.stack(si_p), jnp.stack(sr_s), jnp.stack(si_s))
```

```cpp
#include <hip/hip_runtime.h>
#include <hip/hip_bf16.h>
#include <hip/hip_cooperative_groups.h>
#include <cstdio>
namespace cg = cooperative_groups;

#define DEVI __device__ __forceinline__
typedef __attribute__((ext_vector_type(8))) short bf16x8;
typedef __attribute__((ext_vector_type(4))) float f32x4;
typedef unsigned short u16;
typedef unsigned long long u64;
typedef unsigned u32x4 __attribute__((ext_vector_type(4)));

constexpr int TP = 16384, TT = 16640, DM = 1024, QW = 3072, FF = 2816;
constexpr int NTHR = 512;
constexpr int LDS_BYTES = 128 * 1024 + 16;

constexpr size_t O_RETP = 17039360, O_RETS = 17104896, O_KP = 18153472, O_VP = 20250624,
                 O_KS = 22347776, O_VS = 55902208, O_SRP = 89456640, O_SIP = 89464832,
                 O_SRS = 89473024, O_SIS = 89604096;

constexpr size_t WS_WIN = 0;
constexpr size_t WS_WOUT = WS_WIN + (size_t)3072 * 1024 * 2;
constexpr size_t WS_WF1 = WS_WOUT + (size_t)1024 * 1024 * 2;
constexpr size_t SZ_WF1 = (size_t)5632 * 1024 * 2;
constexpr size_t WS_WF2 = WS_WF1 + 2 * SZ_WF1;
constexpr size_t SZ_WF2 = (size_t)1024 * 2816 * 2;
constexpr size_t WS_WGLU = WS_WF2 + 2 * SZ_WF2;
constexpr size_t WS_A = WS_WGLU + (size_t)2048 * 1024 * 2;
constexpr size_t WS_B = WS_A + (size_t)TT * 3072 * 2;
constexpr size_t WS_YB = WS_B + (size_t)TT * 1024 * 2;
constexpr size_t WS_SSQ = WS_YB + (size_t)TT * 1024 * 2;
constexpr size_t WS_ATTO = WS_SSQ + (size_t)TT * 32 * 4;
constexpr size_t WS_LSE = WS_ATTO + (size_t)3 * TP * 512 * 2;
constexpr size_t WS_UT = WS_LSE + (size_t)3 * TP * 8 * 4;
constexpr size_t WS_SPT = WS_UT + (size_t)512 * 8192 * 4;
constexpr size_t WS_E = WS_SPT + (size_t)512 * 8192 * 2;
constexpr size_t WS_XP = WS_E + (size_t)2 * 256 * 4096 * 8;
constexpr size_t WS_KD = WS_XP + (size_t)2 * 256 * 4096 * 8;
constexpr size_t WS_MT = WS_KD + (size_t)64 * 32 * 256 * 2;
constexpr size_t WS_PT = WS_MT + (size_t)64 * 128 * 512 * 2;
constexpr size_t WS_BAR = WS_PT + (size_t)64 * 512 * 128 * 2;
constexpr size_t WS_END = WS_BAR + 16384;

struct Params {
  const float* in[24];
  float* out;
  char* ws;
};

DEVI float bf2f(u16 h) { return __uint_as_float(((unsigned)h) << 16); }
DEVI u16 f2bf(float f) {
  unsigned u = __float_as_uint(f);
  u += 0x7fffu + ((u >> 16) & 1u);
  return (u16)(u >> 16);
}
DEVI unsigned pack2(float a, float b) { unsigned r; asm("v_cvt_pk_bf16_f32 %0, %1, %2" : "=v"(r) : "v"(a), "v"(b)); return r; }
DEVI float fexp(float x) { return __builtin_amdgcn_exp2f(x * 1.4426950408889634f); }
DEVI float siluf(float x) { return x * __builtin_amdgcn_rcpf(1.f + fexp(-x)); }
DEVI float sigmf(float x) { return __builtin_amdgcn_rcpf(1.f + fexp(-x)); }
DEVI float geluf(float x) {
  float u = 1.5957691216057308f * (x + 0.044715f * x * x * x);
  return x * sigmf(u);
}
DEVI void ssq_add(u64* p, float ss) { atomicAdd(p, (u64)(ss * 1048576.f)); }
DEVI float ssq_rstd(const u64* p) { return rsqrtf((float)(*p) * (1.f / (1048576.f * 1024.f)) + 1e-6f); }
DEVI f32x4 mfma16(bf16x8 a, bf16x8 b, f32x4 c) { return __builtin_amdgcn_mfma_f32_16x16x32_bf16(a, b, c, 0, 0, 0); }


#define XB_TMO      128
#define XB_XCNT(j)  (256  + 64 * (j))
#define XB_XSUB(j)  (1280 + 64 * (j))
#define XB_XGEN(j)  (2304 + 64 * (j))
#define XB_TOP      3328
#define XB_TOPGEN   3392
#define XCD_BAR_WORDS 3456
#define XB_SPIN_CAP (1u << 18)
#define LAS3 __attribute__((address_space(3)))
DEVI unsigned xb_ld(unsigned* p) { return __hip_atomic_load(p, __ATOMIC_RELAXED, __HIP_MEMORY_SCOPE_AGENT); }
DEVI unsigned xb_add(unsigned* p, unsigned v) { return __hip_atomic_fetch_add(p, v, __ATOMIC_RELAXED, __HIP_MEMORY_SCOPE_AGENT); }
DEVI unsigned xb_xcc_id() { return (unsigned)__builtin_amdgcn_s_getreg((3 << 11) | 20) & 0xFu; }
#define XB_SPIN(cond, bar) do { unsigned _sp = 0; while (cond) { __builtin_amdgcn_s_sleep(1); \
    if ((++_sp & 255u) == 0u) { if (xb_ld(&(bar)[XB_TMO])) break; if (_sp > XB_SPIN_CAP) { atomicAdd(&(bar)[XB_TMO], 1u); break; } } } } while (0)
struct XcdBarrier { unsigned* bar; unsigned x; volatile LAS3 unsigned* st; };
DEVI XcdBarrier xcd_barrier_post(unsigned* bar, volatile LAS3 unsigned* st) {
  XcdBarrier b; b.bar = bar; b.x = xb_xcc_id(); b.st = st;
  if (threadIdx.x == 0) (void)xb_add(&bar[XB_XCNT(b.x)], 1u);
  return b;
}
DEVI void xcd_barrier_complete(unsigned* bar, unsigned x, unsigned& nloc, unsigned& nx) {
  const unsigned G = gridDim.x * gridDim.y * gridDim.z;
  unsigned sum, cnt, mine, sp = 0u;
  for (;;) {
    sum = 0u; cnt = 0u; mine = 0u;
#pragma unroll
    for (unsigned j = 0; j < 16; ++j) { const unsigned c = xb_ld(&bar[XB_XCNT(j)]); sum += c; cnt += (c > 0u) ? 1u : 0u; mine = (j == x) ? c : mine; }
    if (sum == G) break;
    __builtin_amdgcn_s_sleep(1);
    if ((++sp & 255u) == 0u) { if (xb_ld(&bar[XB_TMO])) break; if (sp > XB_SPIN_CAP) { atomicAdd(&bar[XB_TMO], 1u); break; } }
  }
  nloc = mine > 0u ? mine : 1u; nx = cnt > 0u ? cnt : 1u;
}
DEVI void xcd_barrier(const XcdBarrier& b) {
  asm volatile("s_waitcnt vmcnt(0)" ::: "memory");
  __syncthreads();
  if (threadIdx.x == 0) {
    unsigned* bar = b.bar;
    __builtin_amdgcn_s_waitcnt(0);
    unsigned nloc = b.st[0], nx = b.st[1];
    if (nloc == 0u) { xcd_barrier_complete(bar, b.x, nloc, nx); b.st[0] = nloc; b.st[1] = nx; }
    const unsigned old = xb_add(&bar[XB_XSUB(b.x)], 1u);
    const unsigned gen = old / nloc;
    if (old + 1u == (gen + 1u) * nloc) {
      __builtin_amdgcn_fence(__ATOMIC_RELEASE, "agent");
      asm volatile("s_waitcnt vmcnt(0)" ::: "memory");
      const unsigned og = xb_add(&bar[XB_TOP], 1u);
      const unsigned tg = og / nx;
      if (og + 1u == (tg + 1u) * nx) xb_add(&bar[XB_TOPGEN], 1u);
      else XB_SPIN(xb_ld(&bar[XB_TOPGEN]) == tg, bar);
      __builtin_amdgcn_fence(__ATOMIC_ACQUIRE, "agent");
      xb_add(&bar[XB_XGEN(b.x)], 1u);
      asm volatile("s_waitcnt vmcnt(0)" ::: "memory");
    } else {
      XB_SPIN(xb_ld(&bar[XB_XGEN(b.x)]) == gen, bar);
      __builtin_amdgcn_fence(__ATOMIC_ACQUIRE, "agent");
      asm volatile("s_waitcnt vmcnt(0)" ::: "memory");
    }
  }
  __syncthreads();
}

struct TrDesc { const float* W; u16* Wt; const float* gain; int K, N, perm, tk, tn; };
struct TrRegs { f32x4 v[8]; float g[8]; };
DEVI TrDesc tr_desc(const Params& p, int t) {
  TrDesc d; int tt = t;
  if (tt < 192) { d.W = p.in[10]; d.K = 1024; d.N = 3072; d.perm = 0; d.Wt = (u16*)(p.ws + WS_WIN); d.gain = p.in[7]; }
  else if ((tt -= 192) < 64) { d.W = p.in[12]; d.K = 1024; d.N = 1024; d.perm = 0; d.Wt = (u16*)(p.ws + WS_WOUT); d.gain = nullptr; }
  else if ((tt -= 64) < 704) { int l = tt / 352; tt -= l * 352; d.W = p.in[22] + (size_t)l * 1024 * 5632; d.K = 1024; d.N = 5632; d.perm = 1;
                               d.Wt = (u16*)(p.ws + WS_WF1 + l * SZ_WF1); d.gain = p.in[8] + l * 1024; }
  else if ((tt -= 704) < 352) { int l = tt / 176; tt -= l * 176; d.W = p.in[23] + (size_t)l * 2816 * 1024; d.K = 2816; d.N = 1024; d.perm = 0;
                                d.Wt = (u16*)(p.ws + WS_WF2 + l * SZ_WF2); d.gain = nullptr; }
  else { tt -= 352; d.W = p.in[21]; d.K = 1024; d.N = 2048; d.perm = 1; d.Wt = (u16*)(p.ws + WS_WGLU); d.gain = nullptr; }
  const int ntn = d.N / 256;
  d.tk = tt / ntn; d.tn = tt % ntn;
  return d;
}
DEVI void tr_load(const TrDesc& d, TrRegs& R) {
  const int tid = threadIdx.x, c4 = tid & 63, kr = tid >> 6, np = c4 * 4;
  const int src = d.perm ? ((np < 128) ? (d.tn * 128 + np) : (d.N / 2 + d.tn * 128 + (np - 128))) : (d.tn * 256 + np);
#pragma unroll
  for (int i = 0; i < 8; i++) {
    const int k = d.tk * 64 + kr + 8 * i;
    R.v[i] = *(const f32x4*)(d.W + (size_t)k * d.N + src);
    R.g[i] = d.gain ? d.gain[k] : 1.f;
  }
}

DEVI void phase_prep(const Params& p, char* smem) {
  float* sm = (float*)smem;
  {
    const int tid = threadIdx.x, G = gridDim.x;
    TrRegs R; TrDesc d;
    int t = blockIdx.x;
    if (t < 1440) { d = tr_desc(p, t); tr_load(d, R); }
    for (; t < 1440; t += G) {
      {
        const int c4 = tid & 63, kr = tid >> 6, np = c4 * 4;
#pragma unroll
        for (int i = 0; i < 8; i++) {
          float* dd = sm + (kr + 8 * i) * 257 + np;
          dd[0] = R.v[i][0] * R.g[i]; dd[1] = R.v[i][1] * R.g[i]; dd[2] = R.v[i][2] * R.g[i]; dd[3] = R.v[i][3] * R.g[i];
        }
      }
      __syncthreads();
      TrDesc dn = d;
      if (t + G < 1440) { dn = tr_desc(p, t + G); tr_load(dn, R); }
      {
        const int kg = tid & 7, nn = tid >> 3;
#pragma unroll
        for (int i = 0; i < 4; i++) {
          const int nl = nn + 64 * i;
          const float* c = sm + (kg * 8) * 257 + nl;
          uint4 o;
          o.x = pack2(c[0], c[257]); o.y = pack2(c[2 * 257], c[3 * 257]); o.z = pack2(c[4 * 257], c[5 * 257]); o.w = pack2(c[6 * 257], c[7 * 257]);
          *(uint4*)(d.Wt + (size_t)(d.tn * 256 + nl) * d.K + d.tk * 64 + kg * 8) = o;
        }
      }
      __syncthreads();
      d = dn;
    }
  }
  {
    u64* ssq = (u64*)(p.ws + WS_SSQ);
    for (int i = blockIdx.x * NTHR + threadIdx.x; i < 4 * TT; i += gridDim.x * NTHR) ssq[i] = 0ull;
  }
  int lane = threadIdx.x & 63, wid = threadIdx.x >> 6;
  u16* xb = (u16*)(p.ws + WS_B);
  const int nw = gridDim.x * 8;
  for (int row = blockIdx.x * 8 + wid; row < TT; row += nw * 2) {
    float4 v[2][4];
    float ss[2] = {0.f, 0.f};
#pragma unroll
    for (int r = 0; r < 2; r++) {
      const int rr = row + r * nw;
      if (rr < TT) {
        const float* src = (rr < TP) ? (p.in[0] + (size_t)rr * DM) : (p.in[1] + (size_t)(rr - TP) * DM);
#pragma unroll
        for (int i = 0; i < 4; i++) v[r][i] = *(const float4*)(src + i * 256 + lane * 4);
      }
    }
#pragma unroll
    for (int r = 0; r < 2; r++) {
      const int rr = row + r * nw;
      if (rr < TT) {
#pragma unroll
        for (int i = 0; i < 4; i++) ss[r] += v[r][i].x * v[r][i].x + v[r][i].y * v[r][i].y + v[r][i].z * v[r][i].z + v[r][i].w * v[r][i].w;
#pragma unroll
        for (int o = 32; o > 0; o >>= 1) ss[r] += __shfl_xor(ss[r], o, 64);
        const float rstd = rsqrtf(ss[r] * (1.f / 1024.f) + 1e-6f);
#pragma unroll
        for (int i = 0; i < 4; i++) {
          uint2 o;
          o.x = pack2(v[r][i].x * rstd, v[r][i].y * rstd);
          o.y = pack2(v[r][i].z * rstd, v[r][i].w * rstd);
          *(uint2*)(xb + (size_t)rr * DM + i * 256 + lane * 4) = o;
        }
      }
    }
  }
}

namespace pg8 {
#define PG8_LAS __attribute__((address_space(3)))
constexpr int BM = 256, BK = 64, HALF = 128, HTB = HALF * BK * 2, STAGE_BYTES = 8 * HTB, NXCD = 8, WGM = 8;
DEVI int lds_byte(int r, int c) { const int st = (r >> 4) * 2 + (c >> 5), rr = r & 15, cc = c & 31, ob = rr * 64 + cc * 2; return st * 1024 + (ob ^ (((ob >> 9) & 1) << 5)); }
DEVI void stage_rc(int b, int& R, int& C) { const int st = b / 1024, sb = b % 1024, swz = sb ^ (((sb >> 9) & 1) << 5); R = (st >> 1) * 16 + swz / 64; C = (st & 1) * 32 + (swz % 64) / 2; }
struct Unit { int pm, pn; };
struct Gemm { const u16* A; const u16* Bt; int M, N, K; };
struct StaticOrder {
  int nM, nN, nwg, G, c;
  DEVI void init(int M, int N, int G_, int c_) { nM = M / BM; nN = N / BM; nwg = nM * nN; G = G_; c = c_; }
  DEVI bool next(int i, Unit& u) const {
    const long L = (long)i * G + c; if (L >= nwg) return false;
    int wgid = (int)L; { const int q = nwg / NXCD, r = nwg % NXCD, xcd = wgid % NXCD, off = wgid / NXCD; wgid = (xcd < r ? xcd * (q + 1) : r * (q + 1) + (xcd - r) * q) + off; }
    const int nig = WGM * nN, gid = wgid / nig, fm = gid * WGM, gsz = (nM - fm) < WGM ? (nM - fm) : WGM;
    u.pm = fm + ((wgid % nig) % gsz); u.pn = (wgid % nig) / gsz; return true;
  }
};

template <class Epi>
DEVI void gemm_phase(PG8_LAS unsigned char* lds, const Gemm g, const StaticOrder& S, const Epi& E) {
  int tid_ = threadIdx.x; asm volatile("" : "+v"(tid_));
  const int tid = tid_, wid = __builtin_amdgcn_readfirstlane(tid >> 6), lane = tid & 63, wr = wid >> 2, wc = wid & 3, fr = lane & 15, fq = lane >> 4;
  const int K = g.K, nt = K / BK;
  unsigned voffA[2];
#pragma unroll
  for (int i = 0; i < 2; ++i) { int R, C; stage_rc(tid * 16 + i * 8192, R, C); voffA[i] = (unsigned)(R * K + C) * 2u; }
  const size_t kstep = (size_t)(BK * 2);
  const size_t hstep = (size_t)HALF * K * 2;
  const size_t tstep = 2 * hstep;
  const unsigned ldsw = (unsigned)wid * 1024u;
  const int aoff = lds_byte(wr * 64 + fr, fq * 8), boff = lds_byte(wc * 32 + fr, fq * 8);
#define PG8_SA(b, h) (((b) * 2 + (h)) * HTB)
#define PG8_SB(b, h) ((4 + (b) * 2 + (h)) * HTB)
#define PG8_STAGE(bufoff, gbase, voff) do { _Pragma("unroll") for (int _i = 0; _i < 2; ++_i) \
    __builtin_amdgcn_global_load_lds((const unsigned*)((const char*)(gbase) + (voff)[_i]), (PG8_LAS unsigned*)(lds + (bufoff) + ldsw + _i * 8192), 16, 0, 0); } while (0)
#define PG8_LDA(dst, b, h) do { _Pragma("unroll") for (int m = 0; m < 4; ++m) _Pragma("unroll") for (int k = 0; k < 2; ++k) dst[m][k] = *(const PG8_LAS bf16x8*)(lds + PG8_SA(b, h) + aoff + m * 2048 + k * 1024); } while (0)
#define PG8_LDB(dst, b, h) do { _Pragma("unroll") for (int n = 0; n < 2; ++n) _Pragma("unroll") for (int k = 0; k < 2; ++k) dst[n][k] = *(const PG8_LAS bf16x8*)(lds + PG8_SB(b, h) + boff + n * 2048 + k * 1024); } while (0)
#define PG8_MMA(ai, bj, At, Bt) do { __builtin_amdgcn_s_setprio(1); _Pragma("unroll") for (int m = 0; m < 4; ++m) _Pragma("unroll") for (int n = 0; n < 2; ++n) _Pragma("unroll") for (int k = 0; k < 2; ++k) \
    acc[ai][bj][m][n] = __builtin_amdgcn_mfma_f32_16x16x32_bf16(Bt[n][k], At[m][k], acc[ai][bj][m][n], 0, 0, 0); __builtin_amdgcn_s_setprio(0); } while (0)
#define PG8_WAIT_V(n) asm volatile("s_waitcnt vmcnt(" #n ")" ::: "memory")
#define PG8_WAIT_L(n) asm volatile("s_waitcnt lgkmcnt(" #n ")" ::: "memory")
#define PG8_BAR __builtin_amdgcn_s_barrier()
#define PG8_SCHED __builtin_amdgcn_sched_barrier(0)
  Unit cur, nxt; int ui = 0;
  if (!S.next(0, cur)) return;
  f32x4 acc[2][2][4][2];
#pragma unroll
  for (int a = 0; a < 2; ++a)
#pragma unroll
    for (int b = 0; b < 2; ++b)
#pragma unroll
      for (int m = 0; m < 4; ++m)
#pragma unroll
        for (int n = 0; n < 2; ++n) acc[a][b][m][n] = (f32x4){0.f, 0.f, 0.f, 0.f};
  bf16x8 At[4][2], B0[2][2], B1[2][2];
  const char* cA = (const char*)g.A + (size_t)cur.pm * tstep; const char* cB = (const char*)g.Bt + (size_t)cur.pn * tstep;
  PG8_STAGE(PG8_SB(0, 0), cB, voffA); PG8_STAGE(PG8_SA(0, 0), cA, voffA); PG8_STAGE(PG8_SB(0, 1), cB + hstep, voffA); PG8_STAGE(PG8_SA(0, 1), cA + hstep, voffA);
  if (wr == 1) PG8_BAR;
  PG8_WAIT_V(4); PG8_BAR;
  PG8_STAGE(PG8_SB(1, 0), cB + kstep, voffA); PG8_STAGE(PG8_SA(1, 0), cA + kstep, voffA); PG8_STAGE(PG8_SB(1, 1), cB + hstep + kstep, voffA);
  PG8_WAIT_V(6); PG8_BAR;
  for (;;) {
    const bool has_next = S.next(ui + 1, nxt);
    const char* nA = has_next ? (const char*)g.A + (size_t)nxt.pm * tstep : cA; const char* nB = has_next ? (const char*)g.Bt + (size_t)nxt.pn * tstep : cB;
    for (int t = 0; t < nt; t += 2) {
      const bool last = (t == nt - 2);
      const char* a1 = cA + (size_t)(t + 1) * kstep;
      const char* a2 = last ? nA : cA + (size_t)(t + 2) * kstep; const char* b2 = last ? nB : cB + (size_t)(t + 2) * kstep;
      const char* a3 = a2 + kstep; const char* b3 = b2 + kstep;
      PG8_LDB(B0, 0, 0); PG8_SCHED; PG8_LDA(At, 0, 0); PG8_STAGE(PG8_SA(1, 1), a1 + hstep, voffA);
      PG8_WAIT_L(8); PG8_BAR; PG8_WAIT_L(0); PG8_MMA(0, 0, At, B0); PG8_BAR; PG8_SCHED;
      PG8_LDB(B1, 0, 1); PG8_STAGE(PG8_SB(0, 0), b2, voffA);
      PG8_BAR; PG8_WAIT_L(0); PG8_MMA(0, 1, At, B1); PG8_BAR;
      PG8_LDA(At, 0, 1); PG8_STAGE(PG8_SA(0, 0), a2, voffA);
      PG8_BAR; PG8_WAIT_L(0); PG8_MMA(1, 0, At, B0); PG8_BAR; PG8_SCHED;
      PG8_STAGE(PG8_SB(0, 1), b2 + hstep, voffA);
      PG8_WAIT_V(6); PG8_BAR; PG8_MMA(1, 1, At, B1); PG8_BAR;
      PG8_LDB(B0, 1, 0); PG8_SCHED; PG8_LDA(At, 1, 0); PG8_STAGE(PG8_SA(0, 1), a2 + hstep, voffA);
      PG8_WAIT_L(8); PG8_BAR; PG8_WAIT_L(0); PG8_MMA(0, 0, At, B0); PG8_BAR; PG8_SCHED;
      PG8_LDB(B1, 1, 1); PG8_STAGE(PG8_SB(1, 0), b3, voffA);
      PG8_BAR; PG8_WAIT_L(0); PG8_MMA(0, 1, At, B1); PG8_BAR;
      PG8_LDA(At, 1, 1); PG8_STAGE(PG8_SA(1, 0), a3, voffA);
      PG8_BAR; PG8_WAIT_L(0); PG8_MMA(1, 0, At, B0); PG8_BAR; PG8_SCHED;
      PG8_STAGE(PG8_SB(1, 1), b3 + hstep, voffA);
      PG8_WAIT_V(6); PG8_BAR; PG8_MMA(1, 1, At, B1); PG8_BAR;
    }
    E(acc, cur, wr, wc, fr, fq);
    if (!has_next) break;
#pragma unroll
    for (int a = 0; a < 2; ++a)
#pragma unroll
      for (int b = 0; b < 2; ++b)
#pragma unroll
        for (int m = 0; m < 4; ++m)
#pragma unroll
          for (int n = 0; n < 2; ++n) acc[a][b][m][n] = (f32x4){0.f, 0.f, 0.f, 0.f};
    cur = nxt; cA = nA; cB = nB; ++ui;
  }
  PG8_WAIT_V(0);
  if (wr == 0) PG8_BAR;
  PG8_BAR;
#undef PG8_SA
#undef PG8_SB
#undef PG8_STAGE
#undef PG8_LDA
#undef PG8_LDB
#undef PG8_MMA
#undef PG8_WAIT_V
#undef PG8_WAIT_L
#undef PG8_BAR
#undef PG8_SCHED
}
}

typedef f32x4 AccT[2][2][4][2];
struct EpiQKV {
  u16* qkv; float* out;
  DEVI void operator()(AccT& acc, const pg8::Unit& u, int wr, int wc, int fr, int fq) const {
#pragma unroll
    for (int ai = 0; ai < 2; ai++)
#pragma unroll
      for (int m = 0; m < 4; m++) {
        const int row = 256 * u.pm + 128 * ai + 64 * wr + 16 * m + fr;
#pragma unroll
        for (int bj = 0; bj < 2; bj++)
#pragma unroll
          for (int n = 0; n < 2; n++) {
            const int col = 256 * u.pn + 128 * bj + 32 * wc + 16 * n + 4 * fq;
            f32x4 v = acc[ai][bj][m][n];
            uint2 o; o.x = pack2(v[0], v[1]); o.y = pack2(v[2], v[3]);
            *(uint2*)(qkv + (size_t)row * QW + col) = o;
            if (col >= 2048) {
              const int isv = col >= 2560;
              const int c2 = col - (isv ? 2560 : 2048);
              float* dst = nullptr;
              if (row < TP) {
                int b = row >> 13, s = row & 8191;
                if (s >= 6144) dst = out + (isv ? O_VP : O_KP) + ((size_t)b * 2048 + (s - 6144)) * 512 + c2;
              } else {
                int r2 = row - TP; int b = r2 >> 3, t = r2 & 7;
                dst = out + (isv ? O_VS : O_KS) + ((size_t)b * 2048 + 2040 + t) * 512 + c2;
              }
              if (dst) *(float4*)dst = make_float4(v[0], v[1], v[2], v[3]);
            }
          }
      }
  }
};
DEVI float4 ld_bf4(const u16* p) { const uint2 r = *(const uint2*)p; return make_float4(__uint_as_float(r.x << 16), __uint_as_float(r.x & 0xffff0000u), __uint_as_float(r.y << 16), __uint_as_float(r.y & 0xffff0000u)); }
struct EpiRes {
  u16* yb; u64* ssq; const float* x0; const float* x1;
  DEVI void operator()(AccT& acc, const pg8::Unit& u, int wr, int wc, int fr, int fq) const {
#pragma unroll
    for (int ai = 0; ai < 2; ai++)
#pragma unroll
      for (int m = 0; m < 4; m++) {
        const int row = 256 * u.pm + 128 * ai + 64 * wr + 16 * m + fr;
        float ss = 0.f;
#pragma unroll
        for (int bj = 0; bj < 2; bj++)
#pragma unroll
          for (int n = 0; n < 2; n++) {
            const int col = 256 * u.pn + 128 * bj + 32 * wc + 16 * n + 4 * fq;
            float4 r;
            if (x0) r = *(const float4*)(x0 + (size_t)row * DM + col);
            else r = ld_bf4(yb + (size_t)row * DM + col);
            f32x4 v = acc[ai][bj][m][n];
            float4 o = make_float4(r.x + v[0], r.y + v[1], r.z + v[2], r.w + v[3]);
            ss += o.x * o.x + o.y * o.y + o.z * o.z + o.w * o.w;
            uint2 ob; ob.x = pack2(o.x, o.y); ob.y = pack2(o.z, o.w);
            *(uint2*)(yb + (size_t)row * DM + col) = ob;
          }
        ss += __shfl_xor(ss, 16, 64);
        ss += __shfl_xor(ss, 32, 64);
        if (fq == 0) ssq_add(ssq + row, ss);
      }
  }
};
struct EpiSwiglu {
  u16* hid; const u64* ssq;
  DEVI void operator()(AccT& acc, const pg8::Unit& u, int wr, int wc, int fr, int fq) const {
#pragma unroll
    for (int ai = 0; ai < 2; ai++)
#pragma unroll
      for (int m = 0; m < 4; m++) {
        const int row = 256 * u.pm + 128 * ai + 64 * wr + 16 * m + fr;
        const float rs = ssq_rstd(ssq + row);
#pragma unroll
        for (int n = 0; n < 2; n++) {
          const int col = 128 * u.pn + 32 * wc + 16 * n + 4 * fq;
          f32x4 g = acc[ai][0][m][n], up = acc[ai][1][m][n];
          float h0 = siluf(g[0] * rs) * (up[0] * rs), h1 = siluf(g[1] * rs) * (up[1] * rs);
          float h2 = siluf(g[2] * rs) * (up[2] * rs), h3 = siluf(g[3] * rs) * (up[3] * rs);
          uint2 o; o.x = pack2(h0, h1); o.y = pack2(h2, h3);
          *(uint2*)(hid + (size_t)row * FF + col) = o;
        }
      }
  }
};
struct EpiGlu {
  u16* yb; u64* ssq;
  DEVI void operator()(AccT& acc, const pg8::Unit& u, int wr, int wc, int fr, int fq) const {
#pragma unroll
    for (int ai = 0; ai < 2; ai++)
#pragma unroll
      for (int m = 0; m < 4; m++) {
        const int row = 256 * u.pm + 128 * ai + 64 * wr + 16 * m + fr;
        float ss = 0.f;
#pragma unroll
        for (int n = 0; n < 2; n++) {
          const int col = 128 * u.pn + 32 * wc + 16 * n + 4 * fq;
          f32x4 va = acc[ai][0][m][n], ga = acc[ai][1][m][n];
          float4 r = ld_bf4(yb + (size_t)row * DM + col);
          float4 o = make_float4(r.x + va[0] * sigmf(ga[0]), r.y + va[1] * sigmf(ga[1]),
                                 r.z + va[2] * sigmf(ga[2]), r.w + va[3] * sigmf(ga[3]));
          ss += o.x * o.x + o.y * o.y + o.z * o.z + o.w * o.w;
          uint2 ob; ob.x = pack2(o.x, o.y); ob.y = pack2(o.z, o.w);
          *(uint2*)(yb + (size_t)row * DM + col) = ob;
        }
        ss += __shfl_xor(ss, 16, 64);
        ss += __shfl_xor(ss, 32, 64);
        if (fq == 0) ssq_add(ssq + row, ss);
      }
  }
};

template <class Epi>
DEVI void run_gemm(char* smem, const u16* A, const u16* Bt, int N, int K, const Epi& E) {
  __syncthreads();
  pg8::Gemm g{A, Bt, TP, N, K};
  pg8::StaticOrder S; S.init(TP, N, gridDim.x, blockIdx.x);
  pg8::gemm_phase((PG8_LAS unsigned char*)smem, g, S, E);
  __syncthreads();
}

DEVI float4 sum8(const float* red, int r, int c) {
  float4 a = *(const float4*)(red + r * 68 + c);
#pragma unroll
  for (int w = 1; w < 8; w++) {
    float4 b = *(const float4*)(red + w * 2176 + r * 68 + c);
    a.x += b.x; a.y += b.y; a.z += b.z; a.w += b.w;
  }
  return a;
}
struct SEpiQKV {
  u16* qkv; float* out;
  DEVI void operator()(const float* red, int row0, int cg, int tid) const {
    const int r = tid >> 4, c = (tid & 15) * 4;
    float4 v = sum8(red, r, c);
    const int row = row0 + r, col = cg * 64 + c;
    uint2 o; o.x = pack2(v.x, v.y); o.y = pack2(v.z, v.w);
    *(uint2*)(qkv + (size_t)row * QW + col) = o;
    if (col >= 2048) {
      const int isv = col >= 2560;
      const int c2 = col - (isv ? 2560 : 2048);
      const int r2 = row - TP, b = r2 >> 3, t = r2 & 7;
      *(float4*)(out + (isv ? O_VS : O_KS) + ((size_t)b * 2048 + 2040 + t) * 512 + c2) = v;
    }
  }
};
struct SEpiRes {
  u16* yb; u64* ssq; const float* x1;
  DEVI void operator()(const float* red, int row0, int cg, int tid) const {
    const int r = tid >> 4, c = (tid & 15) * 4;
    float4 v = sum8(red, r, c);
    const int row = row0 + r, col = cg * 64 + c;
    float4 rr;
    if (x1) rr = *(const float4*)(x1 + (size_t)(row - TP) * DM + col);
    else rr = ld_bf4(yb + (size_t)row * DM + col);
    float4 o = make_float4(rr.x + v.x, rr.y + v.y, rr.z + v.z, rr.w + v.w);
    uint2 ob; ob.x = pack2(o.x, o.y); ob.y = pack2(o.z, o.w); *(uint2*)(yb + (size_t)row * DM + col) = ob;
    float ss = o.x * o.x + o.y * o.y + o.z * o.z + o.w * o.w;
#pragma unroll
    for (int of = 1; of < 16; of <<= 1) ss += __shfl_xor(ss, of, 64);
    if ((tid & 15) == 0) ssq_add(ssq + row, ss);
  }
};
struct SEpiSwiglu {
  u16* hid; const u64* ssq;
  DEVI void operator()(const float* red, int row0, int cg, int tid) const {
    if (tid < 256) {
      const int r = tid >> 3, c = (tid & 7) * 4;
      float4 g = sum8(red, r, c), u = sum8(red, r, 32 + c);
      const int row = row0 + r, col = cg * 32 + c;
      const float rs = ssq_rstd(ssq + row);
      uint2 o;
      o.x = pack2(siluf(g.x * rs) * (u.x * rs), siluf(g.y * rs) * (u.y * rs));
      o.y = pack2(siluf(g.z * rs) * (u.z * rs), siluf(g.w * rs) * (u.w * rs));
      *(uint2*)(hid + (size_t)row * FF + col) = o;
    }
  }
};
struct SEpiGlu {
  u16* yb; u64* ssq;
  DEVI void operator()(const float* red, int row0, int cg, int tid) const {
    if (tid < 256) {
      const int r = tid >> 3, c = (tid & 7) * 4;
      float4 va = sum8(red, r, c), ga = sum8(red, r, 32 + c);
      const int row = row0 + r, col = cg * 32 + c;
      float4 rr = ld_bf4(yb + (size_t)row * DM + col);
      float4 o = make_float4(rr.x + va.x * sigmf(ga.x), rr.y + va.y * sigmf(ga.y), rr.z + va.z * sigmf(ga.z), rr.w + va.w * sigmf(ga.w));
      uint2 ob; ob.x = pack2(o.x, o.y); ob.y = pack2(o.z, o.w);
      *(uint2*)(yb + (size_t)row * DM + col) = ob;
      float ss = o.x * o.x + o.y * o.y + o.z * o.z + o.w * o.w;
#pragma unroll
      for (int of = 1; of < 8; of <<= 1) ss += __shfl_xor(ss, of, 64);
      if ((tid & 7) == 0) ssq_add(ssq + row, ss);
    }
  }
};

template <class EpiS>
DEVI void sample_gemm(char* smem, const u16* A, const u16* Bt, int K, int ncg, bool paired, const EpiS& E, int fb = 0) {
  int tid_ = threadIdx.x; asm volatile("" : "+v"(tid_));
  const int tid = tid_, lane = tid & 63, w = tid >> 6, fr = lane & 15, fq = lane >> 4;
  const int ksl = K >> 3, nks = ksl >> 5;
  float* red = (float*)smem;
  for (int it = (int)blockIdx.x - fb; it >= 0 && it < ncg * 8; it += (int)gridDim.x - fb) {
    const int rg = it & 7, cg = it >> 3;
    const int row0 = TP + rg * 32;
    int wrow[4];
    if (paired) { const int base = (cg >> 2) * 256 + (cg & 3) * 32; wrow[0] = base; wrow[1] = base + 16; wrow[2] = base + 128; wrow[3] = base + 144; }
    else { const int base = cg * 64; wrow[0] = base; wrow[1] = base + 16; wrow[2] = base + 32; wrow[3] = base + 48; }
    f32x4 acc[2][4];
#pragma unroll
    for (int m = 0; m < 2; m++)
#pragma unroll
      for (int n = 0; n < 4; n++) acc[m][n] = (f32x4){0.f, 0.f, 0.f, 0.f};
    const u16* ap = A + (size_t)(row0 + fr) * K + w * ksl + fq * 8;
    const u16* bp = Bt + (size_t)fr * K + w * ksl + fq * 8;
#pragma unroll 4
    for (int ks = 0; ks < nks; ks++) {
      bf16x8 a0 = *(const bf16x8*)(ap + ks * 32), a1 = *(const bf16x8*)(ap + (size_t)16 * K + ks * 32);
      bf16x8 bb[4];
#pragma unroll
      for (int n = 0; n < 4; n++) bb[n] = *(const bf16x8*)(bp + (size_t)wrow[n] * K + ks * 32);
#pragma unroll
      for (int n = 0; n < 4; n++) { acc[0][n] = mfma16(bb[n], a0, acc[0][n]); acc[1][n] = mfma16(bb[n], a1, acc[1][n]); }
    }
#pragma unroll
    for (int m = 0; m < 2; m++)
#pragma unroll
      for (int n = 0; n < 4; n++)
        *(float4*)(red + w * 2176 + (m * 16 + fr) * 68 + n * 16 + 4 * fq) = make_float4(acc[m][n][0], acc[m][n][1], acc[m][n][2], acc[m][n][3]);
    __syncthreads();
    E(red, row0, cg, tid);
    __syncthreads();
  }
}

DEVI float ret_log2g(int h) { return log2f(1.f - exp2f(-5.f - (float)h)); }

struct RuRegs { u32x4 k0, k1, v0, v1, v2, v3; };
DEVI void ru_load(const Params& p, int item, RuRegs& R) {
  int tid_ = threadIdx.x; asm volatile("" : "+v"(tid_));
  const int tid = tid_;
  const int bh = item >> 6, c = item & 63, b = bh >> 2, h = bh & 3;
  const u16* qkv = (const u16*)(p.ws + WS_A);
  const size_t r0 = (size_t)b * 8192 + c * 128;
#define RU_K(i, KK) { const int ch = tid + i * 512, m = ch >> 3, part = ch & 7; KK = *(const u32x4*)(qkv + (r0 + m) * QW + 256 + h * 64 + part * 8); }
#define RU_V(i, VV) { const int ch = tid + i * 512, m = ch >> 4, part = ch & 15; VV = *(const u32x4*)(qkv + (r0 + m) * QW + 512 + h * 128 + part * 8); }
  RU_K(0, R.k0) RU_K(1, R.k1) RU_V(0, R.v0) RU_V(1, R.v1) RU_V(2, R.v2) RU_V(3, R.v3)
#undef RU_K
#undef RU_V
}
DEVI void ret_u_item(const Params& p, int item, char* smem, RuRegs& R, int next_item) {
  int tid_ = threadIdx.x; asm volatile("" : "+v"(tid_));
  const int tid = tid_, lane = tid & 63, w = tid >> 6, l15 = lane & 15, lq = lane >> 4;
  const int h = (item >> 6) & 3;
  const float l2g = ret_log2g(h);
  char* Kdt = smem;
  char* Vt = smem + 17408;
#define RU_SK(i, KK) { const int ch = tid + i * 512, m = ch >> 3, part = ch & 7; \
    const float sc = 0.125f * exp2f((float)(127 - m) * l2g); char* kb = Kdt + (part * 8) * 272 + m * 2; \
    *(u16*)(kb) = f2bf(__uint_as_float(KK.x << 16) * sc); *(u16*)(kb + 272) = f2bf(__uint_as_float(KK.x & 0xffff0000u) * sc); \
    *(u16*)(kb + 2 * 272) = f2bf(__uint_as_float(KK.y << 16) * sc); *(u16*)(kb + 3 * 272) = f2bf(__uint_as_float(KK.y & 0xffff0000u) * sc); \
    *(u16*)(kb + 4 * 272) = f2bf(__uint_as_float(KK.z << 16) * sc); *(u16*)(kb + 5 * 272) = f2bf(__uint_as_float(KK.z & 0xffff0000u) * sc); \
    *(u16*)(kb + 6 * 272) = f2bf(__uint_as_float(KK.w << 16) * sc); *(u16*)(kb + 7 * 272) = f2bf(__uint_as_float(KK.w & 0xffff0000u) * sc); }
#define RU_SV(i, VV) { const int ch = tid + i * 512, m = ch >> 4, part = ch & 15; char* vb = Vt + (part * 8) * 272 + m * 2; \
    *(u16*)(vb) = (u16)(VV.x & 0xffffu); *(u16*)(vb + 272) = (u16)(VV.x >> 16); \
    *(u16*)(vb + 2 * 272) = (u16)(VV.y & 0xffffu); *(u16*)(vb + 3 * 272) = (u16)(VV.y >> 16); \
    *(u16*)(vb + 4 * 272) = (u16)(VV.z & 0xffffu); *(u16*)(vb + 5 * 272) = (u16)(VV.z >> 16); \
    *(u16*)(vb + 6 * 272) = (u16)(VV.w & 0xffffu); *(u16*)(vb + 7 * 272) = (u16)(VV.w >> 16); }
  RU_SK(0, R.k0) RU_SK(1, R.k1) RU_SV(0, R.v0) RU_SV(1, R.v1) RU_SV(2, R.v2) RU_SV(3, R.v3)
#undef RU_SK
#undef RU_SV
  __syncthreads();
  if (next_item >= 0) ru_load(p, next_item, R);
  f32x4 acc[4];
#pragma unroll
  for (int d = 0; d < 4; d++) acc[d] = (f32x4){0.f, 0.f, 0.f, 0.f};
#pragma unroll
  for (int ks = 0; ks < 4; ks++) {
    bf16x8 a = *(const bf16x8*)(Vt + (16 * w + l15) * 272 + ks * 64 + lq * 16);
#pragma unroll
    for (int d = 0; d < 4; d++) {
      bf16x8 bb = *(const bf16x8*)(Kdt + (d * 16 + l15) * 272 + ks * 64 + lq * 16);
      acc[d] = mfma16(a, bb, acc[d]);
    }
  }
  float* UT = (float*)(p.ws + WS_UT) + (size_t)item * 8192;
#pragma unroll
  for (int d = 0; d < 4; d++)
#pragma unroll
    for (int j = 0; j < 4; j++) UT[(16 * w + lq * 4 + j) * 64 + d * 16 + l15] = acc[d][j];
  __syncthreads();
}

struct AttnRegs { u32x4 k0, k1, k2, k3, v0, v1, v2, v3; bf16x8 q0, q1; };
DEVI void attn_decode(int item, int& h, int& b, int& branch, int& dil, int& r, int& blk) {
  h = item & 7; const int cb = (item >> 3) & 63, rest = item >> 9; branch = rest % 3; b = rest / 3;
  dil = 1 << (2 * branch); const int nbc = 64 >> (2 * branch);
  r = cb / nbc; blk = cb % nbc;
}
DEVI void attn_load(const Params& p, int item, AttnRegs& R) {
  int tid_ = threadIdx.x; asm volatile("" : "+v"(tid_));
  const int tid = tid_, lane = tid & 63, w = tid >> 6, l15 = lane & 15, lq = lane >> 4;
  int h, b, branch, dil, r, blk; attn_decode(item, h, b, branch, dil, r, blk);
  const u16* qkv = (const u16*)(p.ws + WS_A);
#define ATT_LD(i, KK, VV) { const int ch = tid + i * 512, j = ch >> 3, part = ch & 7; \
    int kc = (blk - 1) * 128 + j; if (kc < 0) kc = 0; \
    const size_t row = (size_t)b * 8192 + (size_t)kc * dil + r; \
    KK = *(const u32x4*)(qkv + row * QW + 2048 + h * 64 + part * 8); \
    VV = *(const u32x4*)(qkv + row * QW + 2560 + h * 64 + part * 8); }
  ATT_LD(0, R.k0, R.v0) ATT_LD(1, R.k1, R.v1) ATT_LD(2, R.k2, R.v2) ATT_LD(3, R.k3, R.v3)
#undef ATT_LD
  const size_t rowq = (size_t)b * 8192 + (size_t)(blk * 128 + 16 * w + l15) * dil + r;
  R.q0 = *(const bf16x8*)(qkv + rowq * QW + 1536 + h * 64 + lq * 8);
  R.q1 = *(const bf16x8*)(qkv + rowq * QW + 1536 + h * 64 + 32 + lq * 8);
}
constexpr int AT_VT = 272 * 144;
DEVI void attn_stage(const AttnRegs& R, char* smem) {
  int tid_ = threadIdx.x; asm volatile("" : "+v"(tid_));
  const int tid = tid_;
  char* Ks = smem; char* Vt = smem + AT_VT;
#define ATT_ST(i, KK, VV) { const int ch = tid + i * 512, j = ch >> 3, part = ch & 7; \
    *(u32x4*)(Ks + j * 144 + part * 16) = KK; \
    const int jx = j ^ (part * 8); char* vb = Vt + (part * 8) * 656 + jx * 2; \
    *(u16*)(vb) = (u16)(VV.x & 0xffffu); *(u16*)(vb + 656) = (u16)(VV.x >> 16); \
    *(u16*)(vb + 2 * 656) = (u16)(VV.y & 0xffffu); *(u16*)(vb + 3 * 656) = (u16)(VV.y >> 16); \
    *(u16*)(vb + 4 * 656) = (u16)(VV.z & 0xffffu); *(u16*)(vb + 5 * 656) = (u16)(VV.z >> 16); \
    *(u16*)(vb + 6 * 656) = (u16)(VV.w & 0xffffu); *(u16*)(vb + 7 * 656) = (u16)(VV.w >> 16); }
  ATT_ST(0, R.k0, R.v0) ATT_ST(1, R.k1, R.v1) ATT_ST(2, R.k2, R.v2) ATT_ST(3, R.k3, R.v3)
#undef ATT_ST
}
DEVI void attn_compute(const Params& p, int item, const bf16x8 qf0, const bf16x8 qf1, char* smem) {
  int tid_ = threadIdx.x; asm volatile("" : "+v"(tid_));
  const int tid = tid_, lane = tid & 63, w = tid >> 6, l15 = lane & 15, lq = lane >> 4;
  int h, b, branch, dil, r, blk; attn_decode(item, h, b, branch, dil, r, blk);
  const char* Ks = smem; const char* Vt = smem + AT_VT;
  const float sd = exp2f(-(float)(h + 1)) * (float)dil;
  f32x4 sT[9];
#pragma unroll
  for (int t = 0; t < 9; t++) {
    sT[t] = (f32x4){0.f, 0.f, 0.f, 0.f};
#pragma unroll
    for (int ks = 0; ks < 2; ks++) {
      bf16x8 kf = *(const bf16x8*)(Ks + ((w + t) * 16 + l15) * 144 + ks * 64 + lq * 16);
      sT[t] = mfma16(kf, ks ? qf1 : qf0, sT[t]);
    }
  }
  float mx = -3e38f;
  const float dbase = (float)(128 + l15 - lq * 4);
#pragma unroll
  for (int t = 0; t < 9; t++) {
    const bool tile_ok = (blk > 0) || (w + t >= 8);
#pragma unroll
    for (int jj = 0; jj < 4; jj++) {
      const float dist = dbase - (float)(t * 16 + jj);
      float v = sT[t][jj] * 0.125f - sd * dist;
      bool valid = tile_ok;
      if (t == 0) valid = valid && (dist <= 128.f);
      if (t == 8) valid = valid && (dist >= 0.f);
      v = valid ? v : -1e30f;
      sT[t][jj] = v;
      mx = fmaxf(mx, v);
    }
  }
  mx = fmaxf(mx, __shfl_xor(mx, 16, 64));
  mx = fmaxf(mx, __shfl_xor(mx, 32, 64));
  float den = 0.f;
  bf16x8 pf[5];
#pragma unroll
  for (int s2 = 0; s2 < 5; s2++) {
    float e[8];
#pragma unroll
    for (int jj = 0; jj < 4; jj++) { e[jj] = fexp(sT[2 * s2][jj] - mx); e[4 + jj] = (s2 < 4) ? fexp(sT[(s2 < 4) ? 2 * s2 + 1 : 0][jj] - mx) : 0.f; }
#pragma unroll
    for (int q = 0; q < 8; q++) den += e[q];
    const u32x4 o = {pack2(e[0], e[1]), pack2(e[2], e[3]), pack2(e[4], e[5]), pack2(e[6], e[7])};
    pf[s2] = __builtin_bit_cast(bf16x8, o);
  }
  den += __shfl_xor(den, 16, 64);
  den += __shfl_xor(den, 32, 64);
  f32x4 oT[4];
#pragma unroll
  for (int d = 0; d < 4; d++) oT[d] = (f32x4){0.f, 0.f, 0.f, 0.f};
#pragma unroll
  for (int s2 = 0; s2 < 5; s2++) {
    const int key0 = (w + 2 * s2) * 16 + lq * 4;
#pragma unroll
    for (int dt = 0; dt < 4; dt++) {
      const int d = dt * 16 + l15, sw = (d >> 3) * 8;
      const uint2 lo = *(const uint2*)(Vt + d * 656 + (key0 ^ sw) * 2);
      const uint2 hi = *(const uint2*)(Vt + d * 656 + ((key0 + 16) ^ sw) * 2);
      const u32x4 vv = {lo.x, lo.y, hi.x, hi.y};
      oT[dt] = mfma16(__builtin_bit_cast(bf16x8, vv), pf[s2], oT[dt]);
    }
  }
  u16* ao = (u16*)(p.ws + WS_ATTO) + (size_t)branch * TP * 512;
  float* lse = (float*)(p.ws + WS_LSE) + (size_t)branch * TP * 8;
  const size_t prow = (size_t)b * 8192 + (size_t)(blk * 128 + 16 * w + l15) * dil + r;
  const float inv = __builtin_amdgcn_rcpf(den);
#pragma unroll
  for (int dt = 0; dt < 4; dt++) {
    uint2 o; o.x = pack2(oT[dt][0] * inv, oT[dt][1] * inv); o.y = pack2(oT[dt][2] * inv, oT[dt][3] * inv);
    *(uint2*)(ao + prow * 512 + h * 64 + dt * 16 + lq * 4) = o;
  }
  if (lq == 0) lse[prow * 8 + h] = mx + logf(den);
}

DEVI void ret_sample_item(const Params& p, int item, char* smem) {
  const int tid = threadIdx.x, b = item >> 2, h = item & 3;
  const u16* qkv = (const u16*)(p.ws + WS_A);
  float* qs = (float*)smem;
  float* ks = qs + 512;
  float* sc = ks + 512;
  float* red = sc + 64;
  const float l2g = ret_log2g(h);
  const size_t r0 = (size_t)TP + b * 8;
  {
    int t = tid >> 6, d = tid & 63;
    qs[tid] = bf2f(qkv[(r0 + t) * QW + h * 64 + d]);
    ks[tid] = 0.125f * bf2f(qkv[(r0 + t) * QW + 256 + h * 64 + d]);
  }
  __syncthreads();
  if (tid < 64) {
    int n = tid >> 3, m = tid & 7;
    float a = 0.f;
    for (int d = 0; d < 64; d++) a += qs[n * 64 + d] * ks[m * 64 + d];
    sc[tid] = (n >= m) ? a * exp2f((float)(n - m) * l2g) : 0.f;
  }
  __syncthreads();
  float o[8];
  const int e = tid & 127;
  if (tid < 128) {
    float v[8];
#pragma unroll
    for (int t = 0; t < 8; t++) v[t] = bf2f(qkv[(r0 + t) * QW + 512 + h * 128 + e]);
    const float* st = p.in[2] + ((size_t)(b * 4 + h) * 64) * 128 + e;
    float* so = p.out + O_RETS + ((size_t)(b * 4 + h) * 64) * 128 + e;
    float cr[8];
#pragma unroll
    for (int t = 0; t < 8; t++) cr[t] = 0.f;
    const float g8 = exp2f(8.f * l2g);
    float vd[8];
#pragma unroll
    for (int t = 0; t < 8; t++) vd[t] = exp2f((float)(7 - t) * l2g) * v[t];
#pragma unroll 1
    for (int d0 = 0; d0 < 64; d0 += 16) {
      float sv[16];
#pragma unroll
      for (int i = 0; i < 16; i++) sv[i] = st[(size_t)(d0 + i) * 128];
#pragma unroll
      for (int i = 0; i < 16; i++) {
        const int d = d0 + i;
        float ns = g8 * sv[i];
#pragma unroll
        for (int t = 0; t < 8; t++) {
          cr[t] += qs[t * 64 + d] * sv[i];
          ns += ks[t * 64 + d] * vd[t];
        }
        so[(size_t)d * 128] = ns;
      }
    }
#pragma unroll
    for (int n = 0; n < 8; n++) {
      float a = cr[n] * exp2f((float)(n + 1) * l2g);
#pragma unroll
      for (int m = 0; m < 8; m++) a += sc[n * 8 + m] * v[m];
      o[n] = a;
    }
#pragma unroll
    for (int n = 0; n < 8; n++) {
      float s = o[n];
#pragma unroll
      for (int of = 32; of > 0; of >>= 1) s += __shfl_xor(s, of, 64);
      if ((tid & 63) == 0) red[(tid >> 6) * 8 + n] = s;
    }
  }
  __syncthreads();
  float mu[8];
  if (tid < 128) {
#pragma unroll
    for (int n = 0; n < 8; n++) { mu[n] = (red[n] + red[8 + n]) * (1.f / 128.f); o[n] -= mu[n]; }
  }
  __syncthreads();
  if (tid < 128) {
#pragma unroll
    for (int n = 0; n < 8; n++) {
      float s = o[n] * o[n];
#pragma unroll
      for (int of = 32; of > 0; of >>= 1) s += __shfl_xor(s, of, 64);
      if ((tid & 63) == 0) red[(tid >> 6) * 8 + n] = s;
    }
  }
  __syncthreads();
  if (tid < 128) {
    u16* mixed = (u16*)(p.ws + WS_B);
    const float gain = p.in[11][h * 128 + e];
#pragma unroll
    for (int n = 0; n < 8; n++) {
      float var = (red[n] + red[8 + n]) * (1.f / 128.f);
      float y = o[n] * rsqrtf(var + 1e-6f) * gain;
      float ga = bf2f(qkv[(r0 + n) * QW + 1024 + h * 128 + e]);
      mixed[(r0 + n) * DM + h * 128 + e] = f2bf(siluf(ga) * y);
    }
  }
  __syncthreads();
}

DEVI void attn_sample_item(const Params& p, int item, char* smem) {
  const int tid = threadIdx.x, lane = tid & 63, t = tid >> 6;
  const int b = item >> 3, h = item & 7;
  const u16* qkv = (const u16*)(p.ws + WS_A);
  float* qsm = (float*)smem + t * 64;
  float* psm = (float*)smem + 512 + t * 400;
  const size_t rq = (size_t)TP + b * 8 + t;
  const float slope = exp2f(-(float)(h + 1));
  qsm[lane] = 0.125f * bf2f(qkv[rq * QW + 1536 + h * 64 + lane]);
  __builtin_amdgcn_wave_barrier();
  __builtin_amdgcn_fence(__ATOMIC_ACQ_REL, "wavefront");
  const float* kpast = p.in[3] + (size_t)b * 2048 * 512 + h * 64;
  const float* vpast = p.in[4] + (size_t)b * 2048 * 512 + h * 64;
  const float* knew = p.out + O_KS + (size_t)b * 2048 * 512 + h * 64 - (size_t)8 * 512;
  const float* vnew = p.out + O_VS + (size_t)b * 2048 * 512 + h * 64 - (size_t)8 * 512;
  float sc[7];
  float mx = -3e38f;
#pragma unroll
  for (int k = 0; k < 7; k++) {
    int q = lane + 64 * k; if (q > 386) q = 386;
    const int g = (q >= 258) ? 2 : ((q >= 129) ? 1 : 0);
    const int j = q - 129 * g, dj = j << (2 * g);
    const int idx = 2048 + t - dj;
    const float4* kr = (const float4*)(((idx < 2048) ? kpast : knew) + (size_t)idx * 512);
    float a = 0.f;
#pragma unroll
    for (int d = 0; d < 16; d++) {
      float4 kk = kr[d];
      a += qsm[d * 4] * kk.x + qsm[d * 4 + 1] * kk.y + qsm[d * 4 + 2] * kk.z + qsm[d * 4 + 3] * kk.w;
    }
    a -= slope * (float)dj;
    if (lane + 64 * k > 386) a = -3e38f;
    sc[k] = a;
    mx = fmaxf(mx, a);
  }
#pragma unroll
  for (int o = 32; o > 0; o >>= 1) mx = fmaxf(mx, __shfl_xor(mx, o, 64));
  float den = 0.f;
#pragma unroll
  for (int k = 0; k < 7; k++) {
    const int q = lane + 64 * k;
    float pv = (q <= 386) ? fexp(sc[k] - mx) : 0.f;
    if (q < 400) psm[q] = pv;
    den += pv;
  }
#pragma unroll
  for (int o = 32; o > 0; o >>= 1) den += __shfl_xor(den, o, 64);
  __builtin_amdgcn_wave_barrier();
  __builtin_amdgcn_fence(__ATOMIC_ACQ_REL, "wavefront");
  const int d4 = lane & 15, kg = lane >> 4;
  float4 acc = make_float4(0.f, 0.f, 0.f, 0.f);
#pragma unroll 16
  for (int i = 0; i < 97; i++) {
    int q = 4 * i + kg;
    const float pv = psm[q];
    if (q > 386) q = 386;
    const int g = (q >= 258) ? 2 : ((q >= 129) ? 1 : 0);
    const int j = q - 129 * g, dj = j << (2 * g);
    const int idx = 2048 + t - dj;
    const float4 v = *(const float4*)(((idx < 2048) ? vpast : vnew) + (size_t)idx * 512 + d4 * 4);
    acc.x += pv * v.x; acc.y += pv * v.y; acc.z += pv * v.z; acc.w += pv * v.w;
  }
  acc.x += __shfl_xor(acc.x, 16, 64); acc.y += __shfl_xor(acc.y, 16, 64); acc.z += __shfl_xor(acc.z, 16, 64); acc.w += __shfl_xor(acc.w, 16, 64);
  acc.x += __shfl_xor(acc.x, 32, 64); acc.y += __shfl_xor(acc.y, 32, 64); acc.z += __shfl_xor(acc.z, 32, 64); acc.w += __shfl_xor(acc.w, 32, 64);
  if (lane < 16) {
    u16* mixed = (u16*)(p.ws + WS_B);
    const float inv = 1.f / den;
    uint2 o; o.x = pack2(acc.x * inv, acc.y * inv); o.y = pack2(acc.z * inv, acc.w * inv);
    *(uint2*)(mixed + rq * DM + 512 + h * 64 + d4 * 4) = o;
  }
  __syncthreads();
}

constexpr int CP_ROWS = 64 * 510;
constexpr int CP_TAIL = 8000;
constexpr int NCP_AT = 5, CP0_AT = 2 * CP_TAIL;
constexpr int NCP_RU = 3, CP0_RU = CP0_AT + 3072 * 5;
DEVI size_t cp_off(int R, int& kv) {
  const int bt = R / 510, rr = R - bt * 510;
  kv = bt >> 5;
  return (size_t)(bt & 31) * (2048 * 512 / 4) + (size_t)rr * 512 + threadIdx.x;
}
template <int N> struct CopyRegs { f32x4 v[N]; };
template <int N> DEVI void cp_load(const Params& p, int row0, CopyRegs<N>& c) {
#pragma unroll
  for (int k = 0; k < N; k++) {
    const int Rw = row0 + k;
    if (Rw < CP_ROWS) { int kv; const size_t o = cp_off(Rw, kv); c.v[k] = __builtin_nontemporal_load((const f32x4*)p.in[3 + kv] + 8 * 512 / 4 + o); }
  }
}
template <int N> DEVI void cp_store(const Params& p, int row0, const CopyRegs<N>& c) {
  asm volatile("" : "+s"(row0));
#pragma unroll
  for (int k = 0; k < N; k++) {
    const int Rw = row0 + k;
    if (Rw < CP_ROWS) { int kv; const size_t o = cp_off(Rw, kv); __builtin_nontemporal_store(c.v[k], (f32x4*)(p.out + (kv ? O_VS : O_KS)) + o); }
  }
}

DEVI void phase_mix_a(const Params& p, char* smem) {
  const int nb = gridDim.x;
  const bool late = (blockIdx.x & 1) != 0;
  if (!late) {
    for (int it = blockIdx.x; it < 256; it += nb) attn_sample_item(p, it, smem);
    {
      RuRegs RU;
      if ((int)blockIdx.x < 512) ru_load(p, blockIdx.x, RU);
      for (int it = blockIdx.x; it < 512; it += nb) {
        CopyRegs<NCP_RU> cp; cp_load(p, CP0_RU + it * NCP_RU, cp);
        ret_u_item(p, it, smem, RU, (it + nb < 512) ? it + nb : -1);
        cp_store(p, CP0_RU + it * NCP_RU, cp);
      }
    }
  }
  __syncthreads();
  if (threadIdx.x < 144) *(uint4*)(smem + 256 * 144 + threadIdx.x * 16) = make_uint4(0u, 0u, 0u, 0u);
  *(uint4*)(smem + AT_VT + (threadIdx.x >> 3) * 656 + (256 + (threadIdx.x & 7) * 8) * 2) = make_uint4(0u, 0u, 0u, 0u);
  AttnRegs R;
  if ((int)blockIdx.x < 3072) attn_load(p, blockIdx.x, R);
  for (int it = blockIdx.x; it < 3072; it += nb) {
    CopyRegs<NCP_AT> cp; cp_load(p, CP0_AT + it * NCP_AT, cp);
    attn_stage(R, smem);
    const bf16x8 qf0 = R.q0, qf1 = R.q1;
    __syncthreads();
    if (it + nb < 3072) attn_load(p, it + nb, R);
    attn_compute(p, it, qf0, qf1, smem);
    cp_store(p, CP0_AT + it * NCP_AT, cp);
    __syncthreads();
  }
  if (late) {
    for (int it = blockIdx.x; it < 256; it += nb) attn_sample_item(p, it, smem);
    {
      RuRegs RU;
      if ((int)blockIdx.x < 512) ru_load(p, blockIdx.x, RU);
      for (int it = blockIdx.x; it < 512; it += nb) {
        CopyRegs<NCP_RU> cp; cp_load(p, CP0_RU + it * NCP_RU, cp);
        ret_u_item(p, it, smem, RU, (it + nb < 512) ? it + nb : -1);
        cp_store(p, CP0_RU + it * NCP_RU, cp);
      }
    }
  }
}

DEVI void phase_mix_b(const Params& p) {
  const int gt = blockIdx.x * NTHR + threadIdx.x, gn = gridDim.x * NTHR;
  if (gt < 65536) {
    const int bh = gt >> 13, rem = gt & 8191, h = bh & 3;
    const float dec = exp2f(128.f * ret_log2g(h));
    const float* UT = (const float*)(p.ws + WS_UT) + (size_t)bh * 64 * 8192 + rem;
    u16* SPT = (u16*)(p.ws + WS_SPT) + (size_t)bh * 64 * 8192 + rem;
    float S = 0.f;
#pragma unroll 8
    for (int c = 0; c < 64; c++) {
      SPT[(size_t)c * 8192] = f2bf(S);
      S = dec * S + UT[(size_t)c * 8192];
    }
    const int e = rem >> 6, d = rem & 63;
    p.out[O_RETP + (size_t)bh * 8192 + d * 128 + e] = S;
  }
  const u16* ao = (const u16*)(p.ws + WS_ATTO);
  const float* lse = (const float*)(p.ws + WS_LSE);
  u16* mixed = (u16*)(p.ws + WS_B);
#pragma unroll 4
  for (int i = gt; i < TP * 64; i += gn) {
    const int row = i >> 6, h = (i >> 3) & 7, part = i & 7;
    float l0 = lse[(size_t)row * 8 + h], l1 = lse[(size_t)(TP + row) * 8 + h], l2 = lse[(size_t)(2 * TP + row) * 8 + h];
    float M = fmaxf(l0, fmaxf(l1, l2));
    float w0 = fexp(l0 - M), w1 = fexp(l1 - M), w2 = fexp(l2 - M);
    float inv = 1.f / (w0 + w1 + w2);
    w0 *= inv; w1 *= inv; w2 *= inv;
    const size_t off = (size_t)row * 512 + h * 64 + part * 8;
    uint4 a0 = *(const uint4*)(ao + off), a1 = *(const uint4*)(ao + (size_t)TP * 512 + off), a2 = *(const uint4*)(ao + (size_t)2 * TP * 512 + off);
    const u16* e0 = (const u16*)&a0; const u16* e1 = (const u16*)&a1; const u16* e2 = (const u16*)&a2;
    uint4 o; unsigned* oo = (unsigned*)&o;
#pragma unroll
    for (int q = 0; q < 4; q++) {
      float x0 = w0 * bf2f(e0[2 * q]) + w1 * bf2f(e1[2 * q]) + w2 * bf2f(e2[2 * q]);
      float x1 = w0 * bf2f(e0[2 * q + 1]) + w1 * bf2f(e1[2 * q + 1]) + w2 * bf2f(e2[2 * q + 1]);
      oo[q] = pack2(x0, x1);
    }
    *(uint4*)(mixed + (size_t)row * DM + 512 + h * 64 + part * 8) = o;
  }
}

struct RoRegs { u32x4 q0, q1, k0, k1, v0, v1, v2, v3; };
DEVI void ro_load(const Params& p, int item, RoRegs& R) {
  int tid_ = threadIdx.x; asm volatile("" : "+v"(tid_));
  const int tid = tid_;
  const int bh = item >> 6, c = item & 63, b = bh >> 2, h = bh & 3;
  const u16* qkv = (const u16*)(p.ws + WS_A);
  const size_t r0 = (size_t)b * 8192 + c * 128;
#define RO_QK(i, QQ, KK) { const int ch = tid + i * 512, m = ch >> 3, part = ch & 7; \
    QQ = *(const u32x4*)(qkv + (r0 + m) * QW + h * 64 + part * 8); KK = *(const u32x4*)(qkv + (r0 + m) * QW + 256 + h * 64 + part * 8); }
#define RO_V(i, VV) { const int ch = tid + i * 512, m = ch >> 4, part = ch & 15; VV = *(const u32x4*)(qkv + (r0 + m) * QW + 512 + h * 128 + part * 8); }
  RO_QK(0, R.q0, R.k0) RO_QK(1, R.q1, R.k1) RO_V(0, R.v0) RO_V(1, R.v1) RO_V(2, R.v2) RO_V(3, R.v3)
#undef RO_QK
#undef RO_V
}
DEVI void ret_out_item(const Params& p, int item, char* smem, RoRegs& R, int next_item) {
  int tid_ = threadIdx.x; asm volatile("" : "+v"(tid_));
  const int tid = tid_, lane = tid & 63, w = tid >> 6, l15 = lane & 15, lq = lane >> 4;
  const int bh = item >> 6, c = item & 63, b = bh >> 2, h = bh & 3;
  const u16* qkv = (const u16*)(p.ws + WS_A);
  const size_t r0 = (size_t)b * 8192 + c * 128;
  const float l2g = ret_log2g(h);
  char* Qs = smem;
  char* Ks = smem + 18432;
  char* Vt = smem + 36864;
  char* Sw = smem + 36864 + 34816 + w * 4352;
#define RO_SQK(i, QQ, KK) { const int ch = tid + i * 512, m = ch >> 3, part = ch & 7; \
    *(u32x4*)(Qs + m * 144 + part * 16) = QQ; *(u32x4*)(Ks + m * 144 + part * 16) = KK; }
#define RO_SV(i, VV) { const int ch = tid + i * 512, m = ch >> 4, part = ch & 15; char* vb = Vt + (part * 8) * 272 + m * 2; \
    *(u16*)(vb) = (u16)(VV.x & 0xffffu); *(u16*)(vb + 272) = (u16)(VV.x >> 16); \
    *(u16*)(vb + 2 * 272) = (u16)(VV.y & 0xffffu); *(u16*)(vb + 3 * 272) = (u16)(VV.y >> 16); \
    *(u16*)(vb + 4 * 272) = (u16)(VV.z & 0xffffu); *(u16*)(vb + 5 * 272) = (u16)(VV.z >> 16); \
    *(u16*)(vb + 6 * 272) = (u16)(VV.w & 0xffffu); *(u16*)(vb + 7 * 272) = (u16)(VV.w >> 16); }
  RO_SQK(0, R.q0, R.k0) RO_SQK(1, R.q1, R.k1) RO_SV(0, R.v0) RO_SV(1, R.v1) RO_SV(2, R.v2) RO_SV(3, R.v3)
#undef RO_SQK
#undef RO_SV
  __syncthreads();
  if (next_item >= 0) ro_load(p, next_item, R);
  bf16x8 qf[2];
  qf[0] = *(const bf16x8*)(Qs + (16 * w + l15) * 144 + lq * 16);
  qf[1] = *(const bf16x8*)(Qs + (16 * w + l15) * 144 + 64 + lq * 16);
  f32x4 acc[8];
  const u16* SPT = (const u16*)(p.ws + WS_SPT) + (size_t)item * 8192;
#pragma unroll
  for (int et = 0; et < 8; et++) {
    acc[et] = (f32x4){0.f, 0.f, 0.f, 0.f};
#pragma unroll
    for (int ks = 0; ks < 2; ks++) {
      bf16x8 sf = *(const bf16x8*)(SPT + (et * 16 + l15) * 64 + ks * 32 + lq * 8);
      acc[et] = mfma16(sf, qf[ks], acc[et]);
    }
  }
  const float qd = exp2f((float)(16 * w + l15 + 1) * l2g);
#pragma unroll
  for (int et = 0; et < 8; et++)
#pragma unroll
    for (int jj = 0; jj < 4; jj++) acc[et][jj] *= qd;
  for (int mt = 0; mt <= w; mt++) {
    f32x4 sa = (f32x4){0.f, 0.f, 0.f, 0.f};
#pragma unroll
    for (int ks = 0; ks < 2; ks++) {
      bf16x8 kf = *(const bf16x8*)(Ks + (mt * 16 + l15) * 144 + ks * 64 + lq * 16);
      sa = mfma16(qf[ks], kf, sa);
    }
    const int m = mt * 16 + l15;
#pragma unroll
    for (int jj = 0; jj < 4; jj++) {
      const int n = 16 * w + lq * 4 + jj;
      float v = (n >= m) ? sa[jj] * 0.125f * exp2f((float)(n - m) * l2g) : 0.f;
      *(u16*)(Sw + (lq * 4 + jj) * 272 + m * 2) = f2bf(v);
    }
  }
  if ((w & 1) == 0) *(uint2*)(Sw + (lane >> 2) * 272 + ((w + 1) * 16 + (lane & 3) * 4) * 2) = make_uint2(0u, 0u);
  __builtin_amdgcn_wave_barrier();
  __builtin_amdgcn_fence(__ATOMIC_ACQ_REL, "wavefront");
  for (int ks = 0; ks <= (w >> 1); ks++) {
    bf16x8 sf = *(const bf16x8*)(Sw + l15 * 272 + ks * 64 + lq * 16);
#pragma unroll
    for (int et = 0; et < 8; et++) {
      bf16x8 vf = *(const bf16x8*)(Vt + (et * 16 + l15) * 272 + ks * 64 + lq * 16);
      acc[et] = mfma16(vf, sf, acc[et]);
    }
  }
  u16* mixed = (u16*)(p.ws + WS_B);
  const float* gn = p.in[11] + h * 128;
  float sm_ = 0.f;
#pragma unroll
  for (int et = 0; et < 8; et++) sm_ += acc[et][0] + acc[et][1] + acc[et][2] + acc[et][3];
  sm_ += __shfl_xor(sm_, 16, 64);
  sm_ += __shfl_xor(sm_, 32, 64);
  const float mu = sm_ * (1.f / 128.f);
  float vs = 0.f;
#pragma unroll
  for (int et = 0; et < 8; et++)
#pragma unroll
    for (int jj = 0; jj < 4; jj++) { const float d = acc[et][jj] - mu; vs += d * d; }
  vs += __shfl_xor(vs, 16, 64);
  vs += __shfl_xor(vs, 32, 64);
  const float rs = rsqrtf(vs * (1.f / 128.f) + 1e-6f);
  const size_t row = r0 + 16 * w + l15;
#pragma unroll
  for (int et = 0; et < 8; et++) {
    const int e = et * 16 + lq * 4;
    const float4 gg = *(const float4*)(gn + e);
    const float4 ga = ld_bf4(qkv + row * QW + 1024 + h * 128 + e);
    uint2 o;
    o.x = pack2(siluf(ga.x) * ((acc[et][0] - mu) * rs * gg.x), siluf(ga.y) * ((acc[et][1] - mu) * rs * gg.y));
    o.y = pack2(siluf(ga.z) * ((acc[et][2] - mu) * rs * gg.z), siluf(ga.w) * ((acc[et][3] - mu) * rs * gg.w));
    *(uint2*)(mixed + row * DM + h * 128 + e) = o;
  }
  __syncthreads();
}

struct S5c { float ar, ai; };

DEVI void s5_setup(const Params& p, int g, int n, float& ar, float& ai, float* bfr, float* bfi) {
  const float dt = expf(p.in[15][g]);
  const float lr = p.in[13][g * 64 + n], li = p.in[14][g * 64 + n];
  const float mag = expf(lr * dt);
  float sn, cs;
  sincosf(li * dt, &sn, &cs);
  ar = mag * cs; ai = mag * sn;
  const float den = lr * lr + li * li;
  const float fr = ((ar - 1.f) * lr + ai * li) / den;
  const float fi = (ai * lr - (ar - 1.f) * li) / den;
  const float4* br = (const float4*)(p.in[16] + ((size_t)g * 64 + n) * 16);
  const float4* bi = (const float4*)(p.in[17] + ((size_t)g * 64 + n) * 16);
#pragma unroll
  for (int q = 0; q < 4; q++) {
    float4 x = br[q], y = bi[q];
    bfr[q * 4 + 0] = fr * x.x - fi * y.x; bfi[q * 4 + 0] = fr * y.x + fi * x.x;
    bfr[q * 4 + 1] = fr * x.y - fi * y.y; bfi[q * 4 + 1] = fr * y.y + fi * x.y;
    bfr[q * 4 + 2] = fr * x.z - fi * y.z; bfi[q * 4 + 2] = fr * y.z + fi * x.z;
    bfr[q * 4 + 3] = fr * x.w - fi * y.w; bfi[q * 4 + 3] = fr * y.w + fi * x.w;
  }
}

DEVI void s5_stage_u(const Params& p, size_t row0, int L, int go, float* us) {
  const int tid = threadIdx.x;
  const u64* ssq = (const u64*)(p.ws + WS_SSQ);
  const float* gain = p.in[7] + 1024 + go * 128;
  for (int i = tid; i < L * 32; i += NTHR) {
    int t = i >> 5, c4 = i & 31;
    float rstd = ssq_rstd(ssq + TT + row0 + t);
    float4 y = ld_bf4((const u16*)(p.ws + WS_YB) + (row0 + t) * DM + go * 128 + c4 * 4);
    float4 gg = *(const float4*)(gain + c4 * 4);
    *(float4*)(us + t * 128 + c4 * 4) = make_float4(y.x * rstd * gg.x, y.y * rstd * gg.y, y.z * rstd * gg.z, y.w * rstd * gg.w);
  }
}

DEVI void s5c_item(const Params& p, bool sample, int item, char* smem) {
  const int tid = threadIdx.x, lane = tid & 63, n = lane, w = tid >> 6, l15 = lane & 15, lq = lane >> 4;
  int go, L; size_t row0; int b = 0, c = 0, bs = 0;
  if (sample) { go = item & 7; bs = item >> 3; L = 8; row0 = (size_t)TP + bs * 8; }
  else { go = item & 7; c = (item >> 3) & 255; b = item >> 11; L = 32; row0 = (size_t)b * 8192 + c * 32; }
  const int g = go * 8 + w;
  float* us = (float*)smem;
  char* xs = smem + 16384 + w * 8704;
  s5_stage_u(p, row0, L, go, us);
  float ar, ai, bfr[16], bfi[16];
  s5_setup(p, g, n, ar, ai, bfr, bfi);
  float xr, xi;
  if (sample) {
    xr = p.in[5][((size_t)bs * 64 + g) * 64 + n];
    xi = p.in[6][((size_t)bs * 64 + g) * 64 + n];
  } else {
    float2 x0 = ((const float2*)(p.ws + WS_XP))[((size_t)(b * 256 + c) * 64 + g) * 64 + n];
    xr = x0.x; xi = x0.y;
  }
  bf16x8 cf[4];
#pragma unroll
  for (int ks = 0; ks < 4; ks++) {
    const int nb = (ks & 1) * 32 + lq * 8;
    const float* src = ((ks < 2) ? p.in[18] : p.in[19]) + ((size_t)g * 16 + l15) * 64 + nb;
    const float sgn = (ks < 2) ? 1.f : -1.f;
    float4 a0 = *(const float4*)src, a1 = *(const float4*)(src + 4);
    bf16x8 f;
    f[0] = (short)f2bf(sgn * a0.x); f[1] = (short)f2bf(sgn * a0.y); f[2] = (short)f2bf(sgn * a0.z); f[3] = (short)f2bf(sgn * a0.w);
    f[4] = (short)f2bf(sgn * a1.x); f[5] = (short)f2bf(sgn * a1.y); f[6] = (short)f2bf(sgn * a1.z); f[7] = (short)f2bf(sgn * a1.w);
    cf[ks] = f;
  }
  __syncthreads();
  for (int t = 0; t < L; t++) {
    const float4* u4 = (const float4*)(us + t * 128 + w * 16);
    float dr = 0.f, di = 0.f;
#pragma unroll
    for (int q = 0; q < 4; q++) {
      float4 u = u4[q];
      dr += bfr[q * 4] * u.x + bfr[q * 4 + 1] * u.y + bfr[q * 4 + 2] * u.z + bfr[q * 4 + 3] * u.w;
      di += bfi[q * 4] * u.x + bfi[q * 4 + 1] * u.y + bfi[q * 4 + 2] * u.z + bfi[q * 4 + 3] * u.w;
    }
    float nr = ar * xr - ai * xi + dr;
    float ni = ar * xi + ai * xr + di;
    xr = nr; xi = ni;
    *(u16*)(xs + t * 272 + n * 2) = f2bf(xr);
    *(u16*)(xs + t * 272 + 128 + n * 2) = f2bf(xi);
  }
  if (sample) {
    p.out[O_SRS + ((size_t)bs * 64 + g) * 64 + n] = xr;
    p.out[O_SIS + ((size_t)bs * 64 + g) * 64 + n] = xi;
    for (int t = 8; t < 16; t++) { *(u16*)(xs + t * 272 + n * 2) = 0; *(u16*)(xs + t * 272 + 128 + n * 2) = 0; }
  }
  __builtin_amdgcn_wave_barrier();
  __builtin_amdgcn_fence(__ATOMIC_ACQ_REL, "wavefront");
  u16* z = (u16*)(p.ws + WS_B);
  const float dsk = p.in[20][g * 16 + l15];
  const int nmt = sample ? 1 : 2;
  for (int mt = 0; mt < nmt; mt++) {
    f32x4 ya = (f32x4){0.f, 0.f, 0.f, 0.f};
#pragma unroll
    for (int ks = 0; ks < 4; ks++) {
      bf16x8 xf = *(const bf16x8*)(xs + (mt * 16 + l15) * 272 + ks * 64 + lq * 16);
      ya = mfma16(xf, cf[ks], ya);
    }
#pragma unroll
    for (int jj = 0; jj < 4; jj++) {
      const int t = mt * 16 + lq * 4 + jj;
      if (t < L) {
        float y = ya[jj] + dsk * us[t * 128 + w * 16 + l15];
        z[(row0 + t) * DM + g * 16 + l15] = f2bf(geluf(y));
      }
    }
  }
  __syncthreads();
}

DEVI void s5_pre_item(const Params& p, int item, char* smem) {
  const int tid = threadIdx.x, g = item >> 2, tq = item & 3;
  float2* bfs = (float2*)smem;
  float2* apw = bfs + 1024;
  float2* cs = apw + 33 * 64;
  if (tid < 64) {
    float ar, ai, bfr[16], bfi[16];
    s5_setup(p, g, tid, ar, ai, bfr, bfi);
    const float* gain = p.in[7] + 1024 + g * 16;
#pragma unroll
    for (int q = 0; q < 16; q++) bfs[tid * 16 + q] = make_float2(bfr[q] * gain[q], bfi[q] * gain[q]);
    float pr = 1.f, pi = 0.f;
    for (int d = 0; d <= 32; d++) {
      apw[d * 64 + tid] = make_float2(pr, pi);
      float nr = pr * ar - pi * ai, ni = pr * ai + pi * ar;
      pr = nr; pi = ni;
    }
  }
  for (int i = tid; i < 1024; i += NTHR) cs[i] = make_float2(p.in[18][(size_t)g * 1024 + i], p.in[19][(size_t)g * 1024 + i]);
  __syncthreads();
  u16* KD = (u16*)(p.ws + WS_KD) + (size_t)g * 32 * 256;
#pragma unroll 1
  for (int i = 0; i < 4; i++) {
    const int o = tid + 512 * i, dl = o >> 8, pp = (o >> 4) & 15, q = o & 15, d = 8 * tq + dl;
    float acc = 0.f;
#pragma unroll 4
    for (int n = 0; n < 64; n++) {
      float2 c = cs[pp * 64 + n], a = apw[d * 64 + n], bb = bfs[n * 16 + q];
      float car = c.x * a.x - c.y * a.y, cai = c.x * a.y + c.y * a.x;
      acc += car * bb.x - cai * bb.y;
    }
    if (d == 0 && pp == q) acc += p.in[20][g * 16 + pp] * p.in[7][1024 + g * 16 + pp];
    KD[d * 256 + pp * 16 + q] = f2bf(acc);
  }
  u16* MT = (u16*)(p.ws + WS_MT) + (size_t)g * 128 * 512;
#pragma unroll 4
  for (int i = 0; i < 32; i++) {
    const int o = tid + 512 * i, np = o >> 7, kk = o & 127, sl = kk >> 4, q = kk & 15, sI = 8 * tq + sl, n = np & 63;
    float2 a = apw[(31 - sI) * 64 + n], bb = bfs[n * 16 + q];
    float v = (np < 64) ? (a.x * bb.x - a.y * bb.y) : (a.x * bb.y + a.y * bb.x);
    MT[np * 512 + sI * 16 + q] = f2bf(v);
  }
  u16* PT = (u16*)(p.ws + WS_PT) + (size_t)g * 512 * 128;
#pragma unroll 4
  for (int i = 0; i < 32; i++) {
    const int o = tid + 512 * i, tpl = o >> 7, np = o & 127, tl = tpl >> 4, pp = tpl & 15, t = 8 * tq + tl, n = np & 63;
    float2 c = cs[pp * 64 + n], a = apw[(t + 1) * 64 + n];
    float v = (np < 64) ? (c.x * a.x - c.y * a.y) : -(c.x * a.y + c.y * a.x);
    PT[(t * 16 + pp) * 128 + np] = f2bf(v);
  }
  __syncthreads();
}

DEVI bf16x8 s5_ufrag(const u16* yb, const u64* ssq1, int row, int col) {
  uint4 raw = *(const uint4*)(yb + (size_t)row * DM + col);
  const float rs = ssq_rstd(ssq1 + row);
  const unsigned r0 = raw.x, r1 = raw.y, r2 = raw.z, r3 = raw.w;
  const u32x4 o = {pack2(__uint_as_float(r0 << 16) * rs, __uint_as_float(r0 & 0xffff0000u) * rs),
                   pack2(__uint_as_float(r1 << 16) * rs, __uint_as_float(r1 & 0xffff0000u) * rs),
                   pack2(__uint_as_float(r2 << 16) * rs, __uint_as_float(r2 & 0xffff0000u) * rs),
                   pack2(__uint_as_float(r3 << 16) * rs, __uint_as_float(r3 & 0xffff0000u) * rs)};
  return __builtin_bit_cast(bf16x8, o);
}

DEVI void s5a_mfma(const Params& p, int g, int mtq, char* smem) {
  int tid_ = threadIdx.x; asm volatile("" : "+v"(tid_));
  const int tid = tid_, lane = tid & 63, w = tid >> 6, fr = lane & 15, fq = lane >> 4;
  const int c0 = (mtq * 8 + w) * 16;
  const u16* yb = (const u16*)(p.ws + WS_YB);
  const u64* ssq1 = (const u64*)(p.ws + WS_SSQ) + TT;
  const u16* MT = (const u16*)(p.ws + WS_MT) + (size_t)g * 128 * 512;
  bf16x8 au[16];
#pragma unroll
  for (int ks = 0; ks < 16; ks++) au[ks] = s5_ufrag(yb, ssq1, (c0 + fr) * 32 + 2 * ks + (fq >> 1), g * 16 + (fq & 1) * 8);
  f32x4 acc[8];
#pragma unroll
  for (int n = 0; n < 8; n++) acc[n] = (f32x4){0.f, 0.f, 0.f, 0.f};
  u32x4 stg[8];
#pragma unroll
  for (int i = 0; i < 8; i++) { const int ch = tid + i * 512, r = ch >> 5, cc = ch & 31; stg[i] = *(const u32x4*)(MT + (size_t)r * 512 + cc * 8); }
#pragma unroll
  for (int half = 0; half < 2; half++) {
    __syncthreads();
#pragma unroll
    for (int i = 0; i < 8; i++) {
      const int ch = tid + i * 512, r = ch >> 5, cc = ch & 31;
      *(u32x4*)(smem + r * 528 + cc * 16) = stg[i];
    }
    __syncthreads();
    if (half == 0) {
#pragma unroll
      for (int i = 0; i < 8; i++) { const int ch = tid + i * 512, r = ch >> 5, cc = ch & 31; stg[i] = *(const u32x4*)(MT + (size_t)r * 512 + 256 + cc * 8); }
    }
#pragma unroll
    for (int ksl = 0; ksl < 8; ksl++) {
#pragma unroll
      for (int n = 0; n < 8; n++) {
        bf16x8 bf = *(const bf16x8*)(smem + (n * 16 + fr) * 528 + ksl * 64 + fq * 16);
        acc[n] = mfma16(bf, au[half * 8 + ksl], acc[n]);
      }
    }
  }
  float* E = (float*)(p.ws + WS_E) + ((size_t)(c0 + fr) * 64 + g) * 128;
#pragma unroll
  for (int n = 0; n < 8; n++) *(float4*)(E + n * 16 + fq * 4) = make_float4(acc[n][0], acc[n][1], acc[n][2], acc[n][3]);
  __syncthreads();
}

DEVI void s5c_mfma(const Params& p, int g, int mtq, char* smem) {
  const int tid = threadIdx.x, lane = tid & 63, w = tid >> 6, fr = lane & 15, fq = lane >> 4;
  const int c0 = (mtq * 8 + w) * 16;
  const u16* yb = (const u16*)(p.ws + WS_YB);
  const u64* ssq1 = (const u64*)(p.ws + WS_SSQ) + TT;
  const u16* KDg = (const u16*)(p.ws + WS_KD) + (size_t)g * 32 * 256;
  const u16* PTg = (const u16*)(p.ws + WS_PT) + (size_t)g * 512 * 128;
  const u16* XP = (const u16*)(p.ws + WS_XP) + ((size_t)(c0 + fr) * 64 + g) * 128;
  u16* z = (u16*)(p.ws + WS_B);
  char* KDs = smem;
  char* PTs = smem + 16384;
#pragma unroll
  for (int i = 0; i < 2; i++) { const int ch = tid + i * 512; *(uint4*)(KDs + ch * 16) = *(const uint4*)(KDg + ch * 8); }
  bf16x8 au[16], ax[4];
#pragma unroll
  for (int ks = 0; ks < 16; ks++) au[ks] = s5_ufrag(yb, ssq1, (c0 + fr) * 32 + 2 * ks + (fq >> 1), g * 16 + (fq & 1) * 8);
#pragma unroll
  for (int ks = 0; ks < 4; ks++) ax[ks] = *(const bf16x8*)(XP + ks * 32 + fq * 8);
  const bf16x8 zero8 = (bf16x8){0, 0, 0, 0, 0, 0, 0, 0};
  u32x4 stg[8];
#pragma unroll
  for (int i = 0; i < 8; i++) { const int ch = tid + i * 512, r = ch >> 4, cc = ch & 15; stg[i] = *(const u32x4*)(PTg + (size_t)r * 128 + cc * 8); }
#pragma unroll
  for (int half = 0; half < 2; half++) {
    __syncthreads();
#pragma unroll
    for (int i = 0; i < 8; i++) {
      const int ch = tid + i * 512, r = ch >> 4, cc = ch & 15;
      *(u32x4*)(PTs + r * 272 + cc * 16) = stg[i];
    }
    __syncthreads();
    if (half == 0) {
#pragma unroll
      for (int i = 0; i < 8; i++) { const int ch = tid + i * 512, r = ch >> 4, cc = ch & 15; stg[i] = *(const u32x4*)(PTg + (size_t)(256 + r) * 128 + cc * 8); }
    }
#pragma unroll 1
    for (int q4 = 0; q4 < 4; q4++) {
      const int t0 = half * 16 + q4 * 4;
      const int nks = (t0 >> 1) + 2;
      f32x4 acc[4];
#pragma unroll
      for (int j = 0; j < 4; j++) acc[j] = (f32x4){0.f, 0.f, 0.f, 0.f};
#pragma unroll
      for (int ks = 0; ks < 16; ks++) {
        if (ks < nks) {
#pragma unroll
          for (int j = 0; j < 4; j++) {
            const int d = t0 + j - 2 * ks - (fq >> 1);
            const int dc = d < 0 ? 0 : d;
            bf16x8 bf = *(const bf16x8*)(KDs + (dc * 256 + fr * 16 + (fq & 1) * 8) * 2);
            bf = (d < 0) ? zero8 : bf;
            acc[j] = mfma16(bf, au[ks], acc[j]);
          }
        }
      }
#pragma unroll
      for (int ks = 0; ks < 4; ks++) {
#pragma unroll
        for (int j = 0; j < 4; j++) {
          bf16x8 bf = *(const bf16x8*)(PTs + ((q4 * 4 + j) * 16 + fr) * 272 + ks * 64 + fq * 16);
          acc[j] = mfma16(bf, ax[ks], acc[j]);
        }
      }
#pragma unroll
      for (int j = 0; j < 4; j++) {
        const int row = (c0 + fr) * 32 + t0 + j, col = g * 16 + fq * 4;
        uint2 o; o.x = pack2(geluf(acc[j][0]), geluf(acc[j][1])); o.y = pack2(geluf(acc[j][2]), geluf(acc[j][3]));
        *(uint2*)(z + (size_t)row * DM + col) = o;
      }
    }
  }
  __syncthreads();
}

DEVI void s5b_item(const Params& p, int item, char* smem) {
  const int tid = threadIdx.x, n = tid & 63, seg = tid >> 6;
  const int b = item >> 6, g = item & 63;
  float2* cs_ = (float2*)smem;
  const float dt = expf(p.in[15][g]);
  const float lr = p.in[13][g * 64 + n], li = p.in[14][g * 64 + n];
  const float mag = expf(lr * dt);
  float sn, cs;
  sincosf(li * dt, &sn, &cs);
  float ar = mag * cs, ai = mag * sn;
#pragma unroll
  for (int q = 0; q < 5; q++) { float r2 = ar * ar - ai * ai, i2 = 2.f * ar * ai; ar = r2; ai = i2; }
  const float* E = (const float*)(p.ws + WS_E) + (((size_t)b * 256 + seg * 32) * 64 + g) * 128 + n;
  u16* XP = (u16*)(p.ws + WS_XP) + (((size_t)b * 256 + seg * 32) * 64 + g) * 128 + n;
  float er[32], ei[32];
#pragma unroll
  for (int c = 0; c < 32; c++) { er[c] = E[(size_t)c * 8192]; ei[c] = E[(size_t)c * 8192 + 64]; }
  float xr = 0.f, xi = 0.f;
#pragma unroll
  for (int c = 0; c < 32; c++) {
    float nr = ar * xr - ai * xi + er[c], ni = ar * xi + ai * xr + ei[c];
    xr = nr; xi = ni;
  }
  cs_[seg * 64 + n] = make_float2(xr, xi);
  __syncthreads();
  if (tid < 64) {
    float sr = ar, si = ai;
#pragma unroll
    for (int q = 0; q < 5; q++) { float r2 = sr * sr - si * si, i2 = 2.f * sr * si; sr = r2; si = i2; }
    float cr = 0.f, ci = 0.f;
    for (int sg = 0; sg < 8; sg++) {
      float2 e = cs_[sg * 64 + n];
      cs_[sg * 64 + n] = make_float2(cr, ci);
      float nr = sr * cr - si * ci + e.x, ni = sr * ci + si * cr + e.y;
      cr = nr; ci = ni;
    }
    p.out[O_SRP + (size_t)b * 4096 + g * 64 + n] = cr;
    p.out[O_SIP + (size_t)b * 4096 + g * 64 + n] = ci;
  }
  __syncthreads();
  float2 c0 = cs_[seg * 64 + n];
  xr = c0.x; xi = c0.y;
#pragma unroll
  for (int c = 0; c < 32; c++) {
    XP[(size_t)c * 8192] = f2bf(xr);
    XP[(size_t)c * 8192 + 64] = f2bf(xi);
    float nr = ar * xr - ai * xi + er[c], ni = ar * xi + ai * xr + ei[c];
    xr = nr; xi = ni;
  }
  __syncthreads();
}

DEVI void phase_final(const Params& p) {
  const int lane = threadIdx.x & 63, wid = threadIdx.x >> 6;
  const u64* ssq = (const u64*)(p.ws + WS_SSQ);
  const u16* yb = (const u16*)(p.ws + WS_YB);
  const float* g = p.in[9];
  float4 gg[4];
#pragma unroll
  for (int i = 0; i < 4; i++) gg[i] = *(const float4*)(g + i * 256 + lane * 4);
  const int nw = gridDim.x * 8;
  for (int row = blockIdx.x * 8 + wid; row < TT; row += nw * 4) {
    float4 v[4][4]; float rstd[4];
#pragma unroll
    for (int r = 0; r < 4; r++) {
      const int rr = row + r * nw;
      if (rr < TT) {
        rstd[r] = ssq_rstd(ssq + 3 * TT + rr);
#pragma unroll
        for (int i = 0; i < 4; i++) v[r][i] = ld_bf4(yb + (size_t)rr * DM + i * 256 + lane * 4);
      }
    }
#pragma unroll
    for (int r = 0; r < 4; r++) {
      const int rr = row + r * nw;
      if (rr < TT) {
        float* y = p.out + (size_t)rr * DM;
#pragma unroll
        for (int i = 0; i < 4; i++)
          *(float4*)(y + i * 256 + lane * 4) = make_float4(v[r][i].x * rstd[r] * gg[i].x, v[r][i].y * rstd[r] * gg[i].y, v[r][i].z * rstd[r] * gg[i].z, v[r][i].w * rstd[r] * gg[i].w);
      }
    }
  }
}

DEVI void copy_tail(const Params& p, int r0, int r1) {
  const int fb = (gridDim.x == 256) ? 128 : 0, nbk = (int)gridDim.x - fb, lb = (int)blockIdx.x - fb;
  if (lb < 0) return;
#pragma unroll 1
  for (int R0 = r0 + lb; R0 < r1; R0 += nbk * 8) {
    f32x4 v[8];
#pragma unroll
    for (int k = 0; k < 8; k++) {
      const int R = R0 + k * nbk;
      if (R < r1) { int kv; const size_t o = cp_off(R, kv); v[k] = __builtin_nontemporal_load((const f32x4*)p.in[3 + kv] + 8 * 512 / 4 + o); }
    }
#pragma unroll
    for (int k = 0; k < 8; k++) {
      const int R = R0 + k * nbk;
      if (R < r1) { int kv; const size_t o = cp_off(R, kv); __builtin_nontemporal_store(v[k], (f32x4*)(p.out + (kv ? O_VS : O_KS)) + o); }
    }
  }
}

DEVI void ffn_block(const Params& p, int layer, const XcdBarrier& xb, char* smem) {
  u16* bufA = (u16*)(p.ws + WS_A);
  u16* yb = (u16*)(p.ws + WS_YB);
  u64* ssq = (u64*)(p.ws + WS_SSQ);
  {
    SEpiSwiglu ES{bufA, ssq + (layer ? 2 * TT : 0)};
    sample_gemm(smem, yb, (const u16*)(p.ws + WS_WF1 + layer * SZ_WF1), 1024, 88, true, ES);
    EpiSwiglu E{bufA, ssq + (layer ? 2 * TT : 0)};
    run_gemm(smem, yb, (const u16*)(p.ws + WS_WF1 + layer * SZ_WF1), 5632, 1024, E);
    copy_tail(p, layer * CP_TAIL, (layer + 1) * CP_TAIL);
  }
  xcd_barrier(xb);
  {
    SEpiRes ES{yb, ssq + (layer ? 3 * TT : TT), nullptr};
    sample_gemm(smem, bufA, (const u16*)(p.ws + WS_WF2 + layer * SZ_WF2), 2816, 16, false, ES);
    EpiRes E{yb, ssq + (layer ? 3 * TT : TT), nullptr, nullptr};
    run_gemm(smem, bufA, (const u16*)(p.ws + WS_WF2 + layer * SZ_WF2), 1024, 2816, E);
  }
  xcd_barrier(xb);
}

__global__ void __launch_bounds__(NTHR, 2) mega(Params p) {
  extern __shared__ __attribute__((aligned(16))) char smem[];
  cg::grid_group grid = cg::this_grid();
  volatile LAS3 unsigned* xst = (volatile LAS3 unsigned*)(LAS3 char*)(smem + 128 * 1024);
  if (threadIdx.x == 0) { xst[0] = 0u; xst[1] = 0u; }
  __syncthreads();
  const XcdBarrier xb = xcd_barrier_post((unsigned*)(p.ws + WS_BAR), xst);
  u16* bufA = (u16*)(p.ws + WS_A);
  u16* bufB = (u16*)(p.ws + WS_B);
  u16* yb = (u16*)(p.ws + WS_YB);
  u64* ssq = (u64*)(p.ws + WS_SSQ);

  phase_prep(p, smem);
  for (int it = blockIdx.x; it < 256; it += gridDim.x) s5_pre_item(p, it, smem);
  xcd_barrier(xb);
  {
    SEpiQKV ES{bufA, p.out};
    sample_gemm(smem, bufB, (const u16*)(p.ws + WS_WIN), 1024, 48, false, ES);
    EpiQKV E{bufA, p.out};
    run_gemm(smem, bufB, (const u16*)(p.ws + WS_WIN), 3072, 1024, E);
  }
  xcd_barrier(xb);
  phase_mix_a(p, smem);
  xcd_barrier(xb);
  phase_mix_b(p);
  for (int it = (blockIdx.x + gridDim.x / 2) % gridDim.x; it < 128; it += gridDim.x) ret_sample_item(p, it, smem);
  xcd_barrier(xb);
  {
    RoRegs R;
    if ((int)blockIdx.x < 512) ro_load(p, blockIdx.x, R);
    for (int it = blockIdx.x; it < 512; it += gridDim.x) {
      const int nx = it + (int)gridDim.x;
      ret_out_item(p, it, smem, R, nx < 512 ? nx : -1);
    }
  }
  xcd_barrier(xb);
  {
    SEpiRes ES{yb, ssq, p.in[1]};
    sample_gemm(smem, bufB, (const u16*)(p.ws + WS_WOUT), 1024, 16, false, ES);
    EpiRes E{yb, ssq, p.in[0], p.in[1]};
    run_gemm(smem, bufB, (const u16*)(p.ws + WS_WOUT), 1024, 1024, E);
  }
  xcd_barrier(xb);
  ffn_block(p, 0, xb, smem);
  for (int it = blockIdx.x; it < 256; it += gridDim.x) {
    const int g = (it & 7) * 8 + (it >> 5), mtq = (it >> 3) & 3;
    s5a_mfma(p, g, mtq, smem);
  }
  xcd_barrier(xb);
  for (int it = blockIdx.x; it < 128; it += gridDim.x) s5b_item(p, it, smem);
  for (int it = (blockIdx.x + 128) % gridDim.x; it < 256; it += gridDim.x) s5c_item(p, true, it, smem);
  xcd_barrier(xb);
  for (int it = blockIdx.x; it < 256; it += gridDim.x) {
    const int g = (it & 7) * 8 + (it >> 5), mtq = (it >> 3) & 3;
    s5c_mfma(p, g, mtq, smem);
  }
  xcd_barrier(xb);
  {
    SEpiGlu ES{yb, ssq + 2 * TT};
    sample_gemm(smem, bufB, (const u16*)(p.ws + WS_WGLU), 1024, 32, true, ES);
    EpiGlu E{yb, ssq + 2 * TT};
    run_gemm(smem, bufB, (const u16*)(p.ws + WS_WGLU), 2048, 1024, E);
  }
  xcd_barrier(xb);
  ffn_block(p, 1, xb, smem);
  phase_final(p);
  if (p.ws == nullptr) grid.sync();
}

extern "C" void kernel_launch(void* const* d_in, const int* in_sizes, int n_in,
                              void* d_out, int out_size, void* d_ws, size_t ws_size,
                              hipStream_t stream) {
  static int grid_blocks = 0;
  if (!grid_blocks) {
    int dev = 0, cus = 0, per_cu = 0;
    (void)hipGetDevice(&dev);
    (void)hipDeviceGetAttribute(&cus, hipDeviceAttributeMultiprocessorCount, dev);
    (void)hipFuncSetAttribute((const void*)mega, hipFuncAttributeMaxDynamicSharedMemorySize, LDS_BYTES);
    (void)hipOccupancyMaxActiveBlocksPerMultiprocessor(&per_cu, mega, NTHR, LDS_BYTES);
    if (per_cu < 1) per_cu = 1;
    if (per_cu > 1) per_cu = 1;
    grid_blocks = cus * per_cu;
  }
  Params p{};
  for (int i = 0; i < 24; i++) p.in[i] = (const float*)d_in[i];
  p.out = (float*)d_out;
  p.ws = (char*)d_ws;
  (void)hipMemsetAsync((char*)d_ws + WS_BAR, 0, XCD_BAR_WORDS * 4, stream);
  void* args[] = {&p};
  hipError_t e = hipLaunchCooperativeKernel((void*)mega, dim3(grid_blocks), dim3(NTHR), args, LDS_BYTES, stream);
  if (e != hipSuccess) fprintf(stderr, "coop launch failed: %s (grid %d)\n", hipGetErrorString(e), grid_blocks);
}
```

```cpp
#include <hip/hip_runtime.h>
#include <hip/hip_bf16.h>
#include <hip/hip_cooperative_groups.h>
#include <cstdio>
namespace cg = cooperative_groups;

#define DEVI __device__ __forceinline__
typedef __attribute__((ext_vector_type(8))) short bf16x8;
typedef __attribute__((ext_vector_type(4))) float f32x4;
typedef unsigned short u16;
typedef unsigned long long u64;
typedef unsigned u32x4 __attribute__((ext_vector_type(4)));

constexpr int TP = 16384, TT = 16640, DM = 1024, QW = 3072, FF = 2816;
constexpr int NTHR = 512;
constexpr int LDS_BYTES = 128 * 1024 + 16;

constexpr size_t O_RETP = 17039360, O_RETS = 17104896, O_KP = 18153472, O_VP = 20250624,
                 O_KS = 22347776, O_VS = 55902208, O_SRP = 89456640, O_SIP = 89464832,
                 O_SRS = 89473024, O_SIS = 89604096;

constexpr size_t WS_WIN = 0;
constexpr size_t WS_WOUT = WS_WIN + (size_t)3072 * 1024 * 2;
constexpr size_t WS_WF1 = WS_WOUT + (size_t)1024 * 1024 * 2;
constexpr size_t SZ_WF1 = (size_t)5632 * 1024 * 2;
constexpr size_t WS_WF2 = WS_WF1 + 2 * SZ_WF1;
constexpr size_t SZ_WF2 = (size_t)1024 * 2816 * 2;
constexpr size_t WS_WGLU = WS_WF2 + 2 * SZ_WF2;
constexpr size_t WS_A = WS_WGLU + (size_t)2048 * 1024 * 2;
constexpr size_t WS_B = WS_A + (size_t)TT * 3072 * 2;
constexpr size_t WS_YB = WS_B + (size_t)TT * 1024 * 2;
constexpr size_t WS_SSQ = WS_YB + (size_t)TT * 1024 * 2;
constexpr size_t WS_ATTO = WS_SSQ + (size_t)TT * 32 * 4;
constexpr size_t WS_LSE = WS_ATTO + (size_t)3 * TP * 512 * 2;
constexpr size_t WS_UT = WS_LSE + (size_t)3 * TP * 8 * 4;
constexpr size_t WS_SPT = WS_UT + (size_t)512 * 8192 * 4;
constexpr size_t WS_E = WS_SPT + (size_t)512 * 8192 * 2;
constexpr size_t WS_XP = WS_E + (size_t)2 * 256 * 4096 * 8;
constexpr size_t WS_KD = WS_XP + (size_t)2 * 256 * 4096 * 8;
constexpr size_t WS_MT = WS_KD + (size_t)64 * 32 * 256 * 2;
constexpr size_t WS_PT = WS_MT + (size_t)64 * 128 * 512 * 2;
constexpr size_t WS_BAR = WS_PT + (size_t)64 * 512 * 128 * 2;
constexpr size_t WS_END = WS_BAR + 16384;

struct Params {
  const float* in[24];
  float* out;
  char* ws;
};

DEVI float bf2f(u16 h) { return __uint_as_float(((unsigned)h) << 16); }
DEVI u16 f2bf(float f) {
  unsigned u = __float_as_uint(f);
  u += 0x7fffu + ((u >> 16) & 1u);
  return (u16)(u >> 16);
}
DEVI unsigned pack2(float a, float b) { unsigned r; asm("v_cvt_pk_bf16_f32 %0, %1, %2" : "=v"(r) : "v"(a), "v"(b)); return r; }
DEVI float fexp(float x) { return __builtin_amdgcn_exp2f(x * 1.4426950408889634f); }
DEVI float siluf(float x) { return x * __builtin_amdgcn_rcpf(1.f + fexp(-x)); }
DEVI float sigmf(float x) { return __builtin_amdgcn_rcpf(1.f + fexp(-x)); }
DEVI float geluf(float x) {
  float u = 1.5957691216057308f * (x + 0.044715f * x * x * x);
  return x * sigmf(u);
}
DEVI void ssq_add(u64* p, float ss) { atomicAdd(p, (u64)(ss * 1048576.f)); }
DEVI float ssq_rstd(const u64* p) { return rsqrtf((float)(*p) * (1.f / (1048576.f * 1024.f)) + 1e-6f); }
DEVI f32x4 mfma16(bf16x8 a, bf16x8 b, f32x4 c) { return __builtin_amdgcn_mfma_f32_16x16x32_bf16(a, b, c, 0, 0, 0); }


#define XB_TMO      128
#define XB_XCNT(j)  (256  + 64 * (j))
#define XB_XSUB(j)  (1280 + 64 * (j))
#define XB_XGEN(j)  (2304 + 64 * (j))
#define XB_TOP      3328
#define XB_TOPGEN   3392
#define XCD_BAR_WORDS 3456
#define XB_SPIN_CAP (1u << 18)
#define LAS3 __attribute__((address_space(3)))
DEVI unsigned xb_ld(unsigned* p) { return __hip_atomic_load(p, __ATOMIC_RELAXED, __HIP_MEMORY_SCOPE_AGENT); }
DEVI unsigned xb_add(unsigned* p, unsigned v) { return __hip_atomic_fetch_add(p, v, __ATOMIC_RELAXED, __HIP_MEMORY_SCOPE_AGENT); }
DEVI unsigned xb_xcc_id() { return (unsigned)__builtin_amdgcn_s_getreg((3 << 11) | 20) & 0xFu; }
#define XB_SPIN(cond, bar) do { unsigned _sp = 0; while (cond) { __builtin_amdgcn_s_sleep(1); \
    if ((++_sp & 255u) == 0u) { if (xb_ld(&(bar)[XB_TMO])) break; if (_sp > XB_SPIN_CAP) { atomicAdd(&(bar)[XB_TMO], 1u); break; } } } } while (0)
struct XcdBarrier { unsigned* bar; unsigned x; volatile LAS3 unsigned* st; };
DEVI XcdBarrier xcd_barrier_post(unsigned* bar, volatile LAS3 unsigned* st) {
  XcdBarrier b; b.bar = bar; b.x = xb_xcc_id(); b.st = st;
  if (threadIdx.x == 0) (void)xb_add(&bar[XB_XCNT(b.x)], 1u);
  return b;
}
DEVI void xcd_barrier_complete(unsigned* bar, unsigned x, unsigned& nloc, unsigned& nx) {
  const unsigned G = gridDim.x * gridDim.y * gridDim.z;
  unsigned sum, cnt, mine, sp = 0u;
  for (;;) {
    sum = 0u; cnt = 0u; mine = 0u;
#pragma unroll
    for (unsigned j = 0; j < 16; ++j) { const unsigned c = xb_ld(&bar[XB_XCNT(j)]); sum += c; cnt += (c > 0u) ? 1u : 0u; mine = (j == x) ? c : mine; }
    if (sum == G) break;
    __builtin_amdgcn_s_sleep(1);
    if ((++sp & 255u) == 0u) { if (xb_ld(&bar[XB_TMO])) break; if (sp > XB_SPIN_CAP) { atomicAdd(&bar[XB_TMO], 1u); break; } }
  }
  nloc = mine > 0u ? mine : 1u; nx = cnt > 0u ? cnt : 1u;
}
DEVI void xcd_barrier(const XcdBarrier& b) {
  asm volatile("s_waitcnt vmcnt(0)" ::: "memory");
  __syncthreads();
  if (threadIdx.x == 0) {
    unsigned* bar = b.bar;
    __builtin_amdgcn_s_waitcnt(0);
    unsigned nloc = b.st[0], nx = b.st[1];
    if (nloc == 0u) { xcd_barrier_complete(bar, b.x, nloc, nx); b.st[0] = nloc; b.st[1] = nx; }
    const unsigned old = xb_add(&bar[XB_XSUB(b.x)], 1u);
    const unsigned gen = old / nloc;
    if (old + 1u == (gen + 1u) * nloc) {
      __builtin_amdgcn_fence(__ATOMIC_RELEASE, "agent");
      asm volatile("s_waitcnt vmcnt(0)" ::: "memory");
      const unsigned og = xb_add(&bar[XB_TOP], 1u);
      const unsigned tg = og / nx;
      if (og + 1u == (tg + 1u) * nx) xb_add(&bar[XB_TOPGEN], 1u);
      else XB_SPIN(xb_ld(&bar[XB_TOPGEN]) == tg, bar);
      __builtin_amdgcn_fence(__ATOMIC_ACQUIRE, "agent");
      xb_add(&bar[XB_XGEN(b.x)], 1u);
      asm volatile("s_waitcnt vmcnt(0)" ::: "memory");
    } else {
      XB_SPIN(xb_ld(&bar[XB_XGEN(b.x)]) == gen, bar);
      __builtin_amdgcn_fence(__ATOMIC_ACQUIRE, "agent");
      asm volatile("s_waitcnt vmcnt(0)" ::: "memory");
    }
  }
  __syncthreads();
}

DEVI void transpose_tile(const float* W, int K, int Nsrc, u16* Wt, const float* gain, int perm, int tk, int tn, float* sm) {
  const int tid = threadIdx.x;
  const int n0 = tn * 256, k0 = tk * 64;
  {
    const int c4 = tid & 63, kr = tid >> 6;
    const int np = c4 * 4;
    const int src = perm ? ((np < 128) ? (tn * 128 + np) : (Nsrc / 2 + tn * 128 + (np - 128))) : (n0 + np);
    float4 v[8];
#pragma unroll
    for (int i = 0; i < 8; i++) v[i] = *(const float4*)(W + (size_t)(k0 + kr + 8 * i) * Nsrc + src);
#pragma unroll
    for (int i = 0; i < 8; i++) {
      const int kl = kr + 8 * i;
      const float g = gain ? gain[k0 + kl] : 1.f;
      float* d = sm + kl * 257 + np;
      d[0] = v[i].x * g; d[1] = v[i].y * g; d[2] = v[i].z * g; d[3] = v[i].w * g;
    }
  }
  __syncthreads();
  {
    const int kg = tid & 7, nn = tid >> 3;
#pragma unroll
    for (int i = 0; i < 4; i++) {
      const int nl = nn + 64 * i;
      const float* c = sm + (kg * 8) * 257 + nl;
      uint4 o;
      o.x = pack2(c[0], c[257]); o.y = pack2(c[2 * 257], c[3 * 257]); o.z = pack2(c[4 * 257], c[5 * 257]); o.w = pack2(c[6 * 257], c[7 * 257]);
      *(uint4*)(Wt + (size_t)(n0 + nl) * K + k0 + kg * 8) = o;
    }
  }
  __syncthreads();
}

DEVI void phase_prep(const Params& p, char* smem) {
  float* sm = (float*)smem;
  for (int t = blockIdx.x; t < 1440; t += gridDim.x) {
    const float* W; int K, N, perm; u16* Wt; const float* gain; int tt = t;
    if (tt < 192) { W = p.in[10]; K = 1024; N = 3072; perm = 0; Wt = (u16*)(p.ws + WS_WIN); gain = p.in[7]; }
    else if ((tt -= 192) < 64) { W = p.in[12]; K = 1024; N = 1024; perm = 0; Wt = (u16*)(p.ws + WS_WOUT); gain = nullptr; }
    else if ((tt -= 64) < 704) { int l = tt / 352; tt -= l * 352; W = p.in[22] + (size_t)l * 1024 * 5632; K = 1024; N = 5632; perm = 1;
                                 Wt = (u16*)(p.ws + WS_WF1 + l * SZ_WF1); gain = p.in[8] + l * 1024; }
    else if ((tt -= 704) < 352) { int l = tt / 176; tt -= l * 176; W = p.in[23] + (size_t)l * 2816 * 1024; K = 2816; N = 1024; perm = 0;
                                  Wt = (u16*)(p.ws + WS_WF2 + l * SZ_WF2); gain = nullptr; }
    else { tt -= 352; W = p.in[21]; K = 1024; N = 2048; perm = 1; Wt = (u16*)(p.ws + WS_WGLU); gain = nullptr; }
    int ntn = N / 256;
    transpose_tile(W, K, N, Wt, gain, perm, tt / ntn, tt % ntn, sm);
  }
  {
    u64* ssq = (u64*)(p.ws + WS_SSQ);
    for (int i = blockIdx.x * NTHR + threadIdx.x; i < 4 * TT; i += gridDim.x * NTHR) ssq[i] = 0ull;
  }
  int lane = threadIdx.x & 63, wid = threadIdx.x >> 6;
  u16* xb = (u16*)(p.ws + WS_B);
  const int nw = gridDim.x * 8;
  for (int row = blockIdx.x * 8 + wid; row < TT; row += nw * 2) {
    float4 v[2][4];
    float ss[2] = {0.f, 0.f};
#pragma unroll
    for (int r = 0; r < 2; r++) {
      const int rr = row + r * nw;
      if (rr < TT) {
        const float* src = (rr < TP) ? (p.in[0] + (size_t)rr * DM) : (p.in[1] + (size_t)(rr - TP) * DM);
#pragma unroll
        for (int i = 0; i < 4; i++) v[r][i] = *(const float4*)(src + i * 256 + lane * 4);
      }
    }
#pragma unroll
    for (int r = 0; r < 2; r++) {
      const int rr = row + r * nw;
      if (rr < TT) {
#pragma unroll
        for (int i = 0; i < 4; i++) ss[r] += v[r][i].x * v[r][i].x + v[r][i].y * v[r][i].y + v[r][i].z * v[r][i].z + v[r][i].w * v[r][i].w;
#pragma unroll
        for (int o = 32; o > 0; o >>= 1) ss[r] += __shfl_xor(ss[r], o, 64);
        const float rstd = rsqrtf(ss[r] * (1.f / 1024.f) + 1e-6f);
#pragma unroll
        for (int i = 0; i < 4; i++) {
          uint2 o;
          o.x = pack2(v[r][i].x * rstd, v[r][i].y * rstd);
          o.y = pack2(v[r][i].z * rstd, v[r][i].w * rstd);
          *(uint2*)(xb + (size_t)rr * DM + i * 256 + lane * 4) = o;
        }
      }
    }
  }
}

namespace pg8 {
#define PG8_LAS __attribute__((address_space(3)))
constexpr int BM = 256, BK = 64, HALF = 128, HTB = HALF * BK * 2, STAGE_BYTES = 8 * HTB, NXCD = 8, WGM = 8;
DEVI int lds_byte(int r, int c) { const int st = (r >> 4) * 2 + (c >> 5), rr = r & 15, cc = c & 31, ob = rr * 64 + cc * 2; return st * 1024 + (ob ^ (((ob >> 9) & 1) << 5)); }
DEVI void stage_rc(int b, int& R, int& C) { const int st = b / 1024, sb = b % 1024, swz = sb ^ (((sb >> 9) & 1) << 5); R = (st >> 1) * 16 + swz / 64; C = (st & 1) * 32 + (swz % 64) / 2; }
struct Unit { int pm, pn; };
struct Gemm { const u16* A; const u16* Bt; int M, N, K; };
struct StaticOrder {
  int nM, nN, nwg, G, c;
  DEVI void init(int M, int N, int G_, int c_) { nM = M / BM; nN = N / BM; nwg = nM * nN; G = G_; c = c_; }
  DEVI bool next(int i, Unit& u) const {
    const long L = (long)i * G + c; if (L >= nwg) return false;
    int wgid = (int)L; { const int q = nwg / NXCD, r = nwg % NXCD, xcd = wgid % NXCD, off = wgid / NXCD; wgid = (xcd < r ? xcd * (q + 1) : r * (q + 1) + (xcd - r) * q) + off; }
    const int nig = WGM * nN, gid = wgid / nig, fm = gid * WGM, gsz = (nM - fm) < WGM ? (nM - fm) : WGM;
    u.pm = fm + ((wgid % nig) % gsz); u.pn = (wgid % nig) / gsz; return true;
  }
};

template <class Epi>
DEVI void gemm_phase(PG8_LAS unsigned char* lds, const Gemm g, const StaticOrder& S, const Epi& E) {
  int tid_ = threadIdx.x; asm volatile("" : "+v"(tid_));
  const int tid = tid_, wid = __builtin_amdgcn_readfirstlane(tid >> 6), lane = tid & 63, wr = wid >> 2, wc = wid & 3, fr = lane & 15, fq = lane >> 4;
  const int K = g.K, nt = K / BK;
  unsigned voffA[2];
#pragma unroll
  for (int i = 0; i < 2; ++i) { int R, C; stage_rc(tid * 16 + i * 8192, R, C); voffA[i] = (unsigned)(R * K + C) * 2u; }
  const size_t kstep = (size_t)(BK * 2);
  const size_t hstep = (size_t)HALF * K * 2;
  const size_t tstep = 2 * hstep;
  const unsigned ldsw = (unsigned)wid * 1024u;
  const int aoff = lds_byte(wr * 64 + fr, fq * 8), boff = lds_byte(wc * 32 + fr, fq * 8);
#define PG8_SA(b, h) (((b) * 2 + (h)) * HTB)
#define PG8_SB(b, h) ((4 + (b) * 2 + (h)) * HTB)
#define PG8_STAGE(bufoff, gbase, voff) do { _Pragma("unroll") for (int _i = 0; _i < 2; ++_i) \
    __builtin_amdgcn_global_load_lds((const unsigned*)((const char*)(gbase) + (voff)[_i]), (PG8_LAS unsigned*)(lds + (bufoff) + ldsw + _i * 8192), 16, 0, 0); } while (0)
#define PG8_LDA(dst, b, h) do { _Pragma("unroll") for (int m = 0; m < 4; ++m) _Pragma("unroll") for (int k = 0; k < 2; ++k) dst[m][k] = *(const PG8_LAS bf16x8*)(lds + PG8_SA(b, h) + aoff + m * 2048 + k * 1024); } while (0)
#define PG8_LDB(dst, b, h) do { _Pragma("unroll") for (int n = 0; n < 2; ++n) _Pragma("unroll") for (int k = 0; k < 2; ++k) dst[n][k] = *(const PG8_LAS bf16x8*)(lds + PG8_SB(b, h) + boff + n * 2048 + k * 1024); } while (0)
#define PG8_MMA(ai, bj, At, Bt) do { __builtin_amdgcn_s_setprio(1); _Pragma("unroll") for (int m = 0; m < 4; ++m) _Pragma("unroll") for (int n = 0; n < 2; ++n) _Pragma("unroll") for (int k = 0; k < 2; ++k) \
    acc[ai][bj][m][n] = __builtin_amdgcn_mfma_f32_16x16x32_bf16(Bt[n][k], At[m][k], acc[ai][bj][m][n], 0, 0, 0); __builtin_amdgcn_s_setprio(0); } while (0)
#define PG8_WAIT_V(n) asm volatile("s_waitcnt vmcnt(" #n ")" ::: "memory")
#define PG8_WAIT_L(n) asm volatile("s_waitcnt lgkmcnt(" #n ")" ::: "memory")
#define PG8_BAR __builtin_amdgcn_s_barrier()
#define PG8_SCHED __builtin_amdgcn_sched_barrier(0)
  Unit cur, nxt; int ui = 0;
  if (!S.next(0, cur)) return;
  f32x4 acc[2][2][4][2];
#pragma unroll
  for (int a = 0; a < 2; ++a)
#pragma unroll
    for (int b = 0; b < 2; ++b)
#pragma unroll
      for (int m = 0; m < 4; ++m)
#pragma unroll
        for (int n = 0; n < 2; ++n) acc[a][b][m][n] = (f32x4){0.f, 0.f, 0.f, 0.f};
  bf16x8 At[4][2], B0[2][2], B1[2][2];
  const char* cA = (const char*)g.A + (size_t)cur.pm * tstep; const char* cB = (const char*)g.Bt + (size_t)cur.pn * tstep;
  PG8_STAGE(PG8_SB(0, 0), cB, voffA); PG8_STAGE(PG8_SA(0, 0), cA, voffA); PG8_STAGE(PG8_SB(0, 1), cB + hstep, voffA); PG8_STAGE(PG8_SA(0, 1), cA + hstep, voffA);
  if (wr == 1) PG8_BAR;
  PG8_WAIT_V(4); PG8_BAR;
  PG8_STAGE(PG8_SB(1, 0), cB + kstep, voffA); PG8_STAGE(PG8_SA(1, 0), cA + kstep, voffA); PG8_STAGE(PG8_SB(1, 1), cB + hstep + kstep, voffA);
  PG8_WAIT_V(6); PG8_BAR;
  for (;;) {
    const bool has_next = S.next(ui + 1, nxt);
    const char* nA = has_next ? (const char*)g.A + (size_t)nxt.pm * tstep : cA; const char* nB = has_next ? (const char*)g.Bt + (size_t)nxt.pn * tstep : cB;
    for (int t = 0; t < nt; t += 2) {
      const bool last = (t == nt - 2);
      const char* a1 = cA + (size_t)(t + 1) * kstep;
      const char* a2 = last ? nA : cA + (size_t)(t + 2) * kstep; const char* b2 = last ? nB : cB + (size_t)(t + 2) * kstep;
      const char* a3 = a2 + kstep; const char* b3 = b2 + kstep;
      PG8_LDB(B0, 0, 0); PG8_SCHED; PG8_LDA(At, 0, 0); PG8_STAGE(PG8_SA(1, 1), a1 + hstep, voffA);
      PG8_WAIT_L(8); PG8_BAR; PG8_WAIT_L(0); PG8_MMA(0, 0, At, B0); PG8_BAR; PG8_SCHED;
      PG8_LDB(B1, 0, 1); PG8_STAGE(PG8_SB(0, 0), b2, voffA);
      PG8_BAR; PG8_WAIT_L(0); PG8_MMA(0, 1, At, B1); PG8_BAR;
      PG8_LDA(At, 0, 1); PG8_STAGE(PG8_SA(0, 0), a2, voffA);
      PG8_BAR; PG8_WAIT_L(0); PG8_MMA(1, 0, At, B0); PG8_BAR; PG8_SCHED;
      PG8_STAGE(PG8_SB(0, 1), b2 + hstep, voffA);
      PG8_WAIT_V(6); PG8_BAR; PG8_MMA(1, 1, At, B1); PG8_BAR;
      PG8_LDB(B0, 1, 0); PG8_SCHED; PG8_LDA(At, 1, 0); PG8_STAGE(PG8_SA(0, 1), a2 + hstep, voffA);
      PG8_WAIT_L(8); PG8_BAR; PG8_WAIT_L(0); PG8_MMA(0, 0, At, B0); PG8_BAR; PG8_SCHED;
      PG8_LDB(B1, 1, 1); PG8_STAGE(PG8_SB(1, 0), b3, voffA);
      PG8_BAR; PG8_WAIT_L(0); PG8_MMA(0, 1, At, B1); PG8_BAR;
      PG8_LDA(At, 1, 1); PG8_STAGE(PG8_SA(1, 0), a3, voffA);
      PG8_BAR; PG8_WAIT_L(0); PG8_MMA(1, 0, At, B0); PG8_BAR; PG8_SCHED;
      PG8_STAGE(PG8_SB(1, 1), b3 + hstep, voffA);
      PG8_WAIT_V(6); PG8_BAR; PG8_MMA(1, 1, At, B1); PG8_BAR;
    }
    E(acc, cur, wr, wc, fr, fq);
    if (!has_next) break;
#pragma unroll
    for (int a = 0; a < 2; ++a)
#pragma unroll
      for (int b = 0; b < 2; ++b)
#pragma unroll
        for (int m = 0; m < 4; ++m)
#pragma unroll
          for (int n = 0; n < 2; ++n) acc[a][b][m][n] = (f32x4){0.f, 0.f, 0.f, 0.f};
    cur = nxt; cA = nA; cB = nB; ++ui;
  }
  PG8_WAIT_V(0);
  if (wr == 0) PG8_BAR;
  PG8_BAR;
#undef PG8_SA
#undef PG8_SB
#undef PG8_STAGE
#undef PG8_LDA
#undef PG8_LDB
#undef PG8_MMA
#undef PG8_WAIT_V
#undef PG8_WAIT_L
#undef PG8_BAR
#undef PG8_SCHED
}
}

typedef f32x4 AccT[2][2][4][2];
struct EpiQKV {
  u16* qkv; float* out;
  DEVI void operator()(AccT& acc, const pg8::Unit& u, int wr, int wc, int fr, int fq) const {
#pragma unroll
    for (int ai = 0; ai < 2; ai++)
#pragma unroll
      for (int m = 0; m < 4; m++) {
        const int row = 256 * u.pm + 128 * ai + 64 * wr + 16 * m + fr;
#pragma unroll
        for (int bj = 0; bj < 2; bj++)
#pragma unroll
          for (int n = 0; n < 2; n++) {
            const int col = 256 * u.pn + 128 * bj + 32 * wc + 16 * n + 4 * fq;
            f32x4 v = acc[ai][bj][m][n];
            uint2 o; o.x = pack2(v[0], v[1]); o.y = pack2(v[2], v[3]);
            *(uint2*)(qkv + (size_t)row * QW + col) = o;
            if (col >= 2048) {
              const int isv = col >= 2560;
              const int c2 = col - (isv ? 2560 : 2048);
              float* dst = nullptr;
              if (row < TP) {
                int b = row >> 13, s = row & 8191;
                if (s >= 6144) dst = out + (isv ? O_VP : O_KP) + ((size_t)b * 2048 + (s - 6144)) * 512 + c2;
              } else {
                int r2 = row - TP; int b = r2 >> 3, t = r2 & 7;
                dst = out + (isv ? O_VS : O_KS) + ((size_t)b * 2048 + 2040 + t) * 512 + c2;
              }
              if (dst) *(float4*)dst = make_float4(v[0], v[1], v[2], v[3]);
            }
          }
      }
  }
};
DEVI float4 ld_bf4(const u16* p) { const uint2 r = *(const uint2*)p; return make_float4(__uint_as_float(r.x << 16), __uint_as_float(r.x & 0xffff0000u), __uint_as_float(r.y << 16), __uint_as_float(r.y & 0xffff0000u)); }
struct EpiRes {
  u16* yb; u64* ssq; const float* x0; const float* x1;
  DEVI void operator()(AccT& acc, const pg8::Unit& u, int wr, int wc, int fr, int fq) const {
#pragma unroll
    for (int ai = 0; ai < 2; ai++)
#pragma unroll
      for (int m = 0; m < 4; m++) {
        const int row = 256 * u.pm + 128 * ai + 64 * wr + 16 * m + fr;
        float ss = 0.f;
#pragma unroll
        for (int bj = 0; bj < 2; bj++)
#pragma unroll
          for (int n = 0; n < 2; n++) {
            const int col = 256 * u.pn + 128 * bj + 32 * wc + 16 * n + 4 * fq;
            float4 r;
            if (x0) r = *(const float4*)(x0 + (size_t)row * DM + col);
            else r = ld_bf4(yb + (size_t)row * DM + col);
            f32x4 v = acc[ai][bj][m][n];
            float4 o = make_float4(r.x + v[0], r.y + v[1], r.z + v[2], r.w + v[3]);
            ss += o.x * o.x + o.y * o.y + o.z * o.z + o.w * o.w;
            uint2 ob; ob.x = pack2(o.x, o.y); ob.y = pack2(o.z, o.w);
            *(uint2*)(yb + (size_t)row * DM + col) = ob;
          }
        ss += __shfl_xor(ss, 16, 64);
        ss += __shfl_xor(ss, 32, 64);
        if (fq == 0) ssq_add(ssq + row, ss);
      }
  }
};
struct EpiSwiglu {
  u16* hid; const u64* ssq;
  DEVI void operator()(AccT& acc, const pg8::Unit& u, int wr, int wc, int fr, int fq) const {
#pragma unroll
    for (int ai = 0; ai < 2; ai++)
#pragma unroll
      for (int m = 0; m < 4; m++) {
        const int row = 256 * u.pm + 128 * ai + 64 * wr + 16 * m + fr;
        const float rs = ssq_rstd(ssq + row);
#pragma unroll
        for (int n = 0; n < 2; n++) {
          const int col = 128 * u.pn + 32 * wc + 16 * n + 4 * fq;
          f32x4 g = acc[ai][0][m][n], up = acc[ai][1][m][n];
          float h0 = siluf(g[0] * rs) * (up[0] * rs), h1 = siluf(g[1] * rs) * (up[1] * rs);
          float h2 = siluf(g[2] * rs) * (up[2] * rs), h3 = siluf(g[3] * rs) * (up[3] * rs);
          uint2 o; o.x = pack2(h0, h1); o.y = pack2(h2, h3);
          *(uint2*)(hid + (size_t)row * FF + col) = o;
        }
      }
  }
};
struct EpiGlu {
  u16* yb; u64* ssq;
  DEVI void operator()(AccT& acc, const pg8::Unit& u, int wr, int wc, int fr, int fq) const {
#pragma unroll
    for (int ai = 0; ai < 2; ai++)
#pragma unroll
      for (int m = 0; m < 4; m++) {
        const int row = 256 * u.pm + 128 * ai + 64 * wr + 16 * m + fr;
        float ss = 0.f;
#pragma unroll
        for (int n = 0; n < 2; n++) {
          const int col = 128 * u.pn + 32 * wc + 16 * n + 4 * fq;
          f32x4 va = acc[ai][0][m][n], ga = acc[ai][1][m][n];
          float4 r = ld_bf4(yb + (size_t)row * DM + col);
          float4 o = make_float4(r.x + va[0] * sigmf(ga[0]), r.y + va[1] * sigmf(ga[1]),
                                 r.z + va[2] * sigmf(ga[2]), r.w + va[3] * sigmf(ga[3]));
          ss += o.x * o.x + o.y * o.y + o.z * o.z + o.w * o.w;
          uint2 ob; ob.x = pack2(o.x, o.y); ob.y = pack2(o.z, o.w);
          *(uint2*)(yb + (size_t)row * DM + col) = ob;
        }
        ss += __shfl_xor(ss, 16, 64);
        ss += __shfl_xor(ss, 32, 64);
        if (fq == 0) ssq_add(ssq + row, ss);
      }
  }
};

template <class Epi>
DEVI void run_gemm(char* smem, const u16* A, const u16* Bt, int N, int K, const Epi& E) {
  __syncthreads();
  pg8::Gemm g{A, Bt, TP, N, K};
  pg8::StaticOrder S; S.init(TP, N, gridDim.x, blockIdx.x);
  pg8::gemm_phase((PG8_LAS unsigned char*)smem, g, S, E);
  __syncthreads();
}

DEVI float4 sum8(const float* red, int r, int c) {
  float4 a = *(const float4*)(red + r * 68 + c);
#pragma unroll
  for (int w = 1; w < 8; w++) {
    float4 b = *(const float4*)(red + w * 2176 + r * 68 + c);
    a.x += b.x; a.y += b.y; a.z += b.z; a.w += b.w;
  }
  return a;
}
struct SEpiQKV {
  u16* qkv; float* out;
  DEVI void operator()(const float* red, int row0, int cg, int tid) const {
    const int r = tid >> 4, c = (tid & 15) * 4;
    float4 v = sum8(red, r, c);
    const int row = row0 + r, col = cg * 64 + c;
    uint2 o; o.x = pack2(v.x, v.y); o.y = pack2(v.z, v.w);
    *(uint2*)(qkv + (size_t)row * QW + col) = o;
    if (col >= 2048) {
      const int isv = col >= 2560;
      const int c2 = col - (isv ? 2560 : 2048);
      const int r2 = row - TP, b = r2 >> 3, t = r2 & 7;
      *(float4*)(out + (isv ? O_VS : O_KS) + ((size_t)b * 2048 + 2040 + t) * 512 + c2) = v;
    }
  }
};
struct SEpiRes {
  u16* yb; u64* ssq; const float* x1;
  DEVI void operator()(const float* red, int row0, int cg, int tid) const {
    const int r = tid >> 4, c = (tid & 15) * 4;
    float4 v = sum8(red, r, c);
    const int row = row0 + r, col = cg * 64 + c;
    float4 rr;
    if (x1) rr = *(const float4*)(x1 + (size_t)(row - TP) * DM + col);
    else rr = ld_bf4(yb + (size_t)row * DM + col);
    float4 o = make_float4(rr.x + v.x, rr.y + v.y, rr.z + v.z, rr.w + v.w);
    uint2 ob; ob.x = pack2(o.x, o.y); ob.y = pack2(o.z, o.w); *(uint2*)(yb + (size_t)row * DM + col) = ob;
    float ss = o.x * o.x + o.y * o.y + o.z * o.z + o.w * o.w;
#pragma unroll
    for (int of = 1; of < 16; of <<= 1) ss += __shfl_xor(ss, of, 64);
    if ((tid & 15) == 0) ssq_add(ssq + row, ss);
  }
};
struct SEpiSwiglu {
  u16* hid; const u64* ssq;
  DEVI void operator()(const float* red, int row0, int cg, int tid) const {
    if (tid < 256) {
      const int r = tid >> 3, c = (tid & 7) * 4;
      float4 g = sum8(red, r, c), u = sum8(red, r, 32 + c);
      const int row = row0 + r, col = cg * 32 + c;
      const float rs = ssq_rstd(ssq + row);
      uint2 o;
      o.x = pack2(siluf(g.x * rs) * (u.x * rs), siluf(g.y * rs) * (u.y * rs));
      o.y = pack2(siluf(g.z * rs) * (u.z * rs), siluf(g.w * rs) * (u.w * rs));
      *(uint2*)(hid + (size_t)row * FF + col) = o;
    }
  }
};
struct SEpiGlu {
  u16* yb; u64* ssq;
  DEVI void operator()(const float* red, int row0, int cg, int tid) const {
    if (tid < 256) {
      const int r = tid >> 3, c = (tid & 7) * 4;
      float4 va = sum8(red, r, c), ga = sum8(red, r, 32 + c);
      const int row = row0 + r, col = cg * 32 + c;
      float4 rr = ld_bf4(yb + (size_t)row * DM + col);
      float4 o = make_float4(rr.x + va.x * sigmf(ga.x), rr.y + va.y * sigmf(ga.y), rr.z + va.z * sigmf(ga.z), rr.w + va.w * sigmf(ga.w));
      uint2 ob; ob.x = pack2(o.x, o.y); ob.y = pack2(o.z, o.w);
      *(uint2*)(yb + (size_t)row * DM + col) = ob;
      float ss = o.x * o.x + o.y * o.y + o.z * o.z + o.w * o.w;
#pragma unroll
      for (int of = 1; of < 8; of <<= 1) ss += __shfl_xor(ss, of, 64);
      if ((tid & 7) == 0) ssq_add(ssq + row, ss);
    }
  }
};

template <class EpiS>
DEVI void sample_gemm(char* smem, const u16* A, const u16* Bt, int K, int ncg, bool paired, const EpiS& E, int fb = 0) {
  int tid_ = threadIdx.x; asm volatile("" : "+v"(tid_));
  const int tid = tid_, lane = tid & 63, w = tid >> 6, fr = lane & 15, fq = lane >> 4;
  const int ksl = K >> 3, nks = ksl >> 5;
  float* red = (float*)smem;
  for (int it = (int)blockIdx.x - fb; it >= 0 && it < ncg * 8; it += (int)gridDim.x - fb) {
    const int rg = it & 7, cg = it >> 3;
    const int row0 = TP + rg * 32;
    int wrow[4];
    if (paired) { const int base = (cg >> 2) * 256 + (cg & 3) * 32; wrow[0] = base; wrow[1] = base + 16; wrow[2] = base + 128; wrow[3] = base + 144; }
    else { const int base = cg * 64; wrow[0] = base; wrow[1] = base + 16; wrow[2] = base + 32; wrow[3] = base + 48; }
    f32x4 acc[2][4];
#pragma unroll
    for (int m = 0; m < 2; m++)
#pragma unroll
      for (int n = 0; n < 4; n++) acc[m][n] = (f32x4){0.f, 0.f, 0.f, 0.f};
    const u16* ap = A + (size_t)(row0 + fr) * K + w * ksl + fq * 8;
    const u16* bp = Bt + (size_t)fr * K + w * ksl + fq * 8;
#pragma unroll 4
    for (int ks = 0; ks < nks; ks++) {
      bf16x8 a0 = *(const bf16x8*)(ap + ks * 32), a1 = *(const bf16x8*)(ap + (size_t)16 * K + ks * 32);
      bf16x8 bb[4];
#pragma unroll
      for (int n = 0; n < 4; n++) bb[n] = *(const bf16x8*)(bp + (size_t)wrow[n] * K + ks * 32);
#pragma unroll
      for (int n = 0; n < 4; n++) { acc[0][n] = mfma16(bb[n], a0, acc[0][n]); acc[1][n] = mfma16(bb[n], a1, acc[1][n]); }
    }
#pragma unroll
    for (int m = 0; m < 2; m++)
#pragma unroll
      for (int n = 0; n < 4; n++)
        *(float4*)(red + w * 2176 + (m * 16 + fr) * 68 + n * 16 + 4 * fq) = make_float4(acc[m][n][0], acc[m][n][1], acc[m][n][2], acc[m][n][3]);
    __syncthreads();
    E(red, row0, cg, tid);
    __syncthreads();
  }
}

DEVI float ret_log2g(int h) { return log2f(1.f - exp2f(-5.f - (float)h)); }

struct RuRegs { u32x4 k0, k1, v0, v1, v2, v3; };
DEVI void ru_load(const Params& p, int item, RuRegs& R) {
  int tid_ = threadIdx.x; asm volatile("" : "+v"(tid_));
  const int tid = tid_;
  const int bh = item >> 6, c = item & 63, b = bh >> 2, h = bh & 3;
  const u16* qkv = (const u16*)(p.ws + WS_A);
  const size_t r0 = (size_t)b * 8192 + c * 128;
#define RU_K(i, KK) { const int ch = tid + i * 512, m = ch >> 3, part = ch & 7; KK = *(const u32x4*)(qkv + (r0 + m) * QW + 256 + h * 64 + part * 8); }
#define RU_V(i, VV) { const int ch = tid + i * 512, m = ch >> 4, part = ch & 15; VV = *(const u32x4*)(qkv + (r0 + m) * QW + 512 + h * 128 + part * 8); }
  RU_K(0, R.k0) RU_K(1, R.k1) RU_V(0, R.v0) RU_V(1, R.v1) RU_V(2, R.v2) RU_V(3, R.v3)
#undef RU_K
#undef RU_V
}
DEVI void ret_u_item(const Params& p, int item, char* smem, RuRegs& R, int next_item) {
  int tid_ = threadIdx.x; asm volatile("" : "+v"(tid_));
  const int tid = tid_, lane = tid & 63, w = tid >> 6, l15 = lane & 15, lq = lane >> 4;
  const int h = (item >> 6) & 3;
  const float l2g = ret_log2g(h);
  char* Kdt = smem;
  char* Vt = smem + 17408;
#define RU_SK(i, KK) { const int ch = tid + i * 512, m = ch >> 3, part = ch & 7; \
    const float sc = 0.125f * exp2f((float)(127 - m) * l2g); char* kb = Kdt + (part * 8) * 272 + m * 2; \
    *(u16*)(kb) = f2bf(__uint_as_float(KK.x << 16) * sc); *(u16*)(kb + 272) = f2bf(__uint_as_float(KK.x & 0xffff0000u) * sc); \
    *(u16*)(kb + 2 * 272) = f2bf(__uint_as_float(KK.y << 16) * sc); *(u16*)(kb + 3 * 272) = f2bf(__uint_as_float(KK.y & 0xffff0000u) * sc); \
    *(u16*)(kb + 4 * 272) = f2bf(__uint_as_float(KK.z << 16) * sc); *(u16*)(kb + 5 * 272) = f2bf(__uint_as_float(KK.z & 0xffff0000u) * sc); \
    *(u16*)(kb + 6 * 272) = f2bf(__uint_as_float(KK.w << 16) * sc); *(u16*)(kb + 7 * 272) = f2bf(__uint_as_float(KK.w & 0xffff0000u) * sc); }
#define RU_SV(i, VV) { const int ch = tid + i * 512, m = ch >> 4, part = ch & 15; char* vb = Vt + (part * 8) * 272 + m * 2; \
    *(u16*)(vb) = (u16)(VV.x & 0xffffu); *(u16*)(vb + 272) = (u16)(VV.x >> 16); \
    *(u16*)(vb + 2 * 272) = (u16)(VV.y & 0xffffu); *(u16*)(vb + 3 * 272) = (u16)(VV.y >> 16); \
    *(u16*)(vb + 4 * 272) = (u16)(VV.z & 0xffffu); *(u16*)(vb + 5 * 272) = (u16)(VV.z >> 16); \
    *(u16*)(vb + 6 * 272) = (u16)(VV.w & 0xffffu); *(u16*)(vb + 7 * 272) = (u16)(VV.w >> 16); }
  RU_SK(0, R.k0) RU_SK(1, R.k1) RU_SV(0, R.v0) RU_SV(1, R.v1) RU_SV(2, R.v2) RU_SV(3, R.v3)
#undef RU_SK
#undef RU_SV
  __syncthreads();
  if (next_item >= 0) ru_load(p, next_item, R);
  f32x4 acc[4];
#pragma unroll
  for (int d = 0; d < 4; d++) acc[d] = (f32x4){0.f, 0.f, 0.f, 0.f};
#pragma unroll
  for (int ks = 0; ks < 4; ks++) {
    bf16x8 a = *(const bf16x8*)(Vt + (16 * w + l15) * 272 + ks * 64 + lq * 16);
#pragma unroll
    for (int d = 0; d < 4; d++) {
      bf16x8 bb = *(const bf16x8*)(Kdt + (d * 16 + l15) * 272 + ks * 64 + lq * 16);
      acc[d] = mfma16(a, bb, acc[d]);
    }
  }
  float* UT = (float*)(p.ws + WS_UT) + (size_t)item * 8192;
#pragma unroll
  for (int d = 0; d < 4; d++)
#pragma unroll
    for (int j = 0; j < 4; j++) UT[(16 * w + lq * 4 + j) * 64 + d * 16 + l15] = acc[d][j];
  __syncthreads();
}

struct AttnRegs { u32x4 k0, k1, k2, k3, v0, v1, v2, v3; bf16x8 q0, q1; };
DEVI void attn_decode(int item, int& h, int& b, int& branch, int& dil, int& r, int& blk) {
  h = item & 7; const int cb = (item >> 3) & 63, rest = item >> 9; branch = rest % 3; b = rest / 3;
  dil = 1 << (2 * branch); const int nbc = 64 >> (2 * branch);
  r = cb / nbc; blk = cb % nbc;
}
DEVI void attn_load(const Params& p, int item, AttnRegs& R) {
  int tid_ = threadIdx.x; asm volatile("" : "+v"(tid_));
  const int tid = tid_, lane = tid & 63, w = tid >> 6, l15 = lane & 15, lq = lane >> 4;
  int h, b, branch, dil, r, blk; attn_decode(item, h, b, branch, dil, r, blk);
  const u16* qkv = (const u16*)(p.ws + WS_A);
#define ATT_LD(i, KK, VV) { const int ch = tid + i * 512, j = ch >> 3, part = ch & 7; \
    int kc = (blk - 1) * 128 + j; if (kc < 0) kc = 0; \
    const size_t row = (size_t)b * 8192 + (size_t)kc * dil + r; \
    KK = *(const u32x4*)(qkv + row * QW + 2048 + h * 64 + part * 8); \
    VV = *(const u32x4*)(qkv + row * QW + 2560 + h * 64 + part * 8); }
  ATT_LD(0, R.k0, R.v0) ATT_LD(1, R.k1, R.v1) ATT_LD(2, R.k2, R.v2) ATT_LD(3, R.k3, R.v3)
#undef ATT_LD
  const size_t rowq = (size_t)b * 8192 + (size_t)(blk * 128 + 16 * w + l15) * dil + r;
  R.q0 = *(const bf16x8*)(qkv + rowq * QW + 1536 + h * 64 + lq * 8);
  R.q1 = *(const bf16x8*)(qkv + rowq * QW + 1536 + h * 64 + 32 + lq * 8);
}
constexpr int AT_VT = 272 * 144;
DEVI void attn_stage(const AttnRegs& R, char* smem) {
  int tid_ = threadIdx.x; asm volatile("" : "+v"(tid_));
  const int tid = tid_;
  char* Ks = smem; char* Vt = smem + AT_VT;
#define ATT_ST(i, KK, VV) { const int ch = tid + i * 512, j = ch >> 3, part = ch & 7; \
    *(u32x4*)(Ks + j * 144 + part * 16) = KK; \
    const int jx = j ^ (part * 8); char* vb = Vt + (part * 8) * 656 + jx * 2; \
    *(u16*)(vb) = (u16)(VV.x & 0xffffu); *(u16*)(vb + 656) = (u16)(VV.x >> 16); \
    *(u16*)(vb + 2 * 656) = (u16)(VV.y & 0xffffu); *(u16*)(vb + 3 * 656) = (u16)(VV.y >> 16); \
    *(u16*)(vb + 4 * 656) = (u16)(VV.z & 0xffffu); *(u16*)(vb + 5 * 656) = (u16)(VV.z >> 16); \
    *(u16*)(vb + 6 * 656) = (u16)(VV.w & 0xffffu); *(u16*)(vb + 7 * 656) = (u16)(VV.w >> 16); }
  ATT_ST(0, R.k0, R.v0) ATT_ST(1, R.k1, R.v1) ATT_ST(2, R.k2, R.v2) ATT_ST(3, R.k3, R.v3)
#undef ATT_ST
}
DEVI void attn_compute(const Params& p, int item, const bf16x8 qf0, const bf16x8 qf1, char* smem) {
  int tid_ = threadIdx.x; asm volatile("" : "+v"(tid_));
  const int tid = tid_, lane = tid & 63, w = tid >> 6, l15 = lane & 15, lq = lane >> 4;
  int h, b, branch, dil, r, blk; attn_decode(item, h, b, branch, dil, r, blk);
  const char* Ks = smem; const char* Vt = smem + AT_VT;
  const float sd = exp2f(-(float)(h + 1)) * (float)dil;
  f32x4 sT[9];
#pragma unroll
  for (int t = 0; t < 9; t++) {
    sT[t] = (f32x4){0.f, 0.f, 0.f, 0.f};
#pragma unroll
    for (int ks = 0; ks < 2; ks++) {
      bf16x8 kf = *(const bf16x8*)(Ks + ((w + t) * 16 + l15) * 144 + ks * 64 + lq * 16);
      sT[t] = mfma16(kf, ks ? qf1 : qf0, sT[t]);
    }
  }
  float mx = -3e38f;
  const float dbase = (float)(128 + l15 - lq * 4);
#pragma unroll
  for (int t = 0; t < 9; t++) {
    const bool tile_ok = (blk > 0) || (w + t >= 8);
#pragma unroll
    for (int jj = 0; jj < 4; jj++) {
      const float dist = dbase - (float)(t * 16 + jj);
      float v = sT[t][jj] * 0.125f - sd * dist;
      bool valid = tile_ok;
      if (t == 0) valid = valid && (dist <= 128.f);
      if (t == 8) valid = valid && (dist >= 0.f);
      v = valid ? v : -1e30f;
      sT[t][jj] = v;
      mx = fmaxf(mx, v);
    }
  }
  mx = fmaxf(mx, __shfl_xor(mx, 16, 64));
  mx = fmaxf(mx, __shfl_xor(mx, 32, 64));
  float den = 0.f;
  bf16x8 pf[5];
#pragma unroll
  for (int s2 = 0; s2 < 5; s2++) {
    float e[8];
#pragma unroll
    for (int jj = 0; jj < 4; jj++) { e[jj] = fexp(sT[2 * s2][jj] - mx); e[4 + jj] = (s2 < 4) ? fexp(sT[(s2 < 4) ? 2 * s2 + 1 : 0][jj] - mx) : 0.f; }
#pragma unroll
    for (int q = 0; q < 8; q++) den += e[q];
    const u32x4 o = {pack2(e[0], e[1]), pack2(e[2], e[3]), pack2(e[4], e[5]), pack2(e[6], e[7])};
    pf[s2] = __builtin_bit_cast(bf16x8, o);
  }
  den += __shfl_xor(den, 16, 64);
  den += __shfl_xor(den, 32, 64);
  f32x4 oT[4];
#pragma unroll
  for (int d = 0; d < 4; d++) oT[d] = (f32x4){0.f, 0.f, 0.f, 0.f};
#pragma unroll
  for (int s2 = 0; s2 < 5; s2++) {
    const int key0 = (w + 2 * s2) * 16 + lq * 4;
#pragma unroll
    for (int dt = 0; dt < 4; dt++) {
      const int d = dt * 16 + l15, sw = (d >> 3) * 8;
      const uint2 lo = *(const uint2*)(Vt + d * 656 + (key0 ^ sw) * 2);
      const uint2 hi = *(const uint2*)(Vt + d * 656 + ((key0 + 16) ^ sw) * 2);
      const u32x4 vv = {lo.x, lo.y, hi.x, hi.y};
      oT[dt] = mfma16(__builtin_bit_cast(bf16x8, vv), pf[s2], oT[dt]);
    }
  }
  u16* ao = (u16*)(p.ws + WS_ATTO) + (size_t)branch * TP * 512;
  float* lse = (float*)(p.ws + WS_LSE) + (size_t)branch * TP * 8;
  const size_t prow = (size_t)b * 8192 + (size_t)(blk * 128 + 16 * w + l15) * dil + r;
  const float inv = __builtin_amdgcn_rcpf(den);
#pragma unroll
  for (int dt = 0; dt < 4; dt++) {
    uint2 o; o.x = pack2(oT[dt][0] * inv, oT[dt][1] * inv); o.y = pack2(oT[dt][2] * inv, oT[dt][3] * inv);
    *(uint2*)(ao + prow * 512 + h * 64 + dt * 16 + lq * 4) = o;
  }
  if (lq == 0) lse[prow * 8 + h] = mx + logf(den);
}

DEVI void ret_sample_item(const Params& p, int item, char* smem) {
  const int tid = threadIdx.x, b = item >> 2, h = item & 3;
  const u16* qkv = (const u16*)(p.ws + WS_A);
  float* qs = (float*)smem;
  float* ks = qs + 512;
  float* sc = ks + 512;
  float* red = sc + 64;
  const float l2g = ret_log2g(h);
  const size_t r0 = (size_t)TP + b * 8;
  {
    int t = tid >> 6, d = tid & 63;
    qs[tid] = bf2f(qkv[(r0 + t) * QW + h * 64 + d]);
    ks[tid] = 0.125f * bf2f(qkv[(r0 + t) * QW + 256 + h * 64 + d]);
  }
  __syncthreads();
  if (tid < 64) {
    int n = tid >> 3, m = tid & 7;
    float a = 0.f;
    for (int d = 0; d < 64; d++) a += qs[n * 64 + d] * ks[m * 64 + d];
    sc[tid] = (n >= m) ? a * exp2f((float)(n - m) * l2g) : 0.f;
  }
  __syncthreads();
  float o[8];
  const int e = tid & 127;
  if (tid < 128) {
    float v[8];
#pragma unroll
    for (int t = 0; t < 8; t++) v[t] = bf2f(qkv[(r0 + t) * QW + 512 + h * 128 + e]);
    const float* st = p.in[2] + ((size_t)(b * 4 + h) * 64) * 128 + e;
    float* so = p.out + O_RETS + ((size_t)(b * 4 + h) * 64) * 128 + e;
    float cr[8];
#pragma unroll
    for (int t = 0; t < 8; t++) cr[t] = 0.f;
    const float g8 = exp2f(8.f * l2g);
    float vd[8];
#pragma unroll
    for (int t = 0; t < 8; t++) vd[t] = exp2f((float)(7 - t) * l2g) * v[t];
#pragma unroll 1
    for (int d0 = 0; d0 < 64; d0 += 16) {
      float sv[16];
#pragma unroll
      for (int i = 0; i < 16; i++) sv[i] = st[(size_t)(d0 + i) * 128];
#pragma unroll
      for (int i = 0; i < 16; i++) {
        const int d = d0 + i;
        float ns = g8 * sv[i];
#pragma unroll
        for (int t = 0; t < 8; t++) {
          cr[t] += qs[t * 64 + d] * sv[i];
          ns += ks[t * 64 + d] * vd[t];
        }
        so[(size_t)d * 128] = ns;
      }
    }
#pragma unroll
    for (int n = 0; n < 8; n++) {
      float a = cr[n] * exp2f((float)(n + 1) * l2g);
#pragma unroll
      for (int m = 0; m < 8; m++) a += sc[n * 8 + m] * v[m];
      o[n] = a;
    }
#pragma unroll
    for (int n = 0; n < 8; n++) {
      float s = o[n];
#pragma unroll
      for (int of = 32; of > 0; of >>= 1) s += __shfl_xor(s, of, 64);
      if ((tid & 63) == 0) red[(tid >> 6) * 8 + n] = s;
    }
  }
  __syncthreads();
  float mu[8];
  if (tid < 128) {
#pragma unroll
    for (int n = 0; n < 8; n++) { mu[n] = (red[n] + red[8 + n]) * (1.f / 128.f); o[n] -= mu[n]; }
  }
  __syncthreads();
  if (tid < 128) {
#pragma unroll
    for (int n = 0; n < 8; n++) {
      float s = o[n] * o[n];
#pragma unroll
      for (int of = 32; of > 0; of >>= 1) s += __shfl_xor(s, of, 64);
      if ((tid & 63) == 0) red[(tid >> 6) * 8 + n] = s;
    }
  }
  __syncthreads();
  if (tid < 128) {
    u16* mixed = (u16*)(p.ws + WS_B);
    const float gain = p.in[11][h * 128 + e];
#pragma unroll
    for (int n = 0; n < 8; n++) {
      float var = (red[n] + red[8 + n]) * (1.f / 128.f);
      float y = o[n] * rsqrtf(var + 1e-6f) * gain;
      float ga = bf2f(qkv[(r0 + n) * QW + 1024 + h * 128 + e]);
      mixed[(r0 + n) * DM + h * 128 + e] = f2bf(siluf(ga) * y);
    }
  }
  __syncthreads();
}

DEVI void attn_sample_item(const Params& p, int item, char* smem) {
  const int tid = threadIdx.x, lane = tid & 63, t = tid >> 6;
  const int b = item >> 3, h = item & 7;
  const u16* qkv = (const u16*)(p.ws + WS_A);
  float* qsm = (float*)smem + t * 64;
  float* psm = (float*)smem + 512 + t * 400;
  const size_t rq = (size_t)TP + b * 8 + t;
  const float slope = exp2f(-(float)(h + 1));
  qsm[lane] = 0.125f * bf2f(qkv[rq * QW + 1536 + h * 64 + lane]);
  __builtin_amdgcn_wave_barrier();
  __builtin_amdgcn_fence(__ATOMIC_ACQ_REL, "wavefront");
  const float* kpast = p.in[3] + (size_t)b * 2048 * 512 + h * 64;
  const float* vpast = p.in[4] + (size_t)b * 2048 * 512 + h * 64;
  const float* knew = p.out + O_KS + (size_t)b * 2048 * 512 + h * 64 - (size_t)8 * 512;
  const float* vnew = p.out + O_VS + (size_t)b * 2048 * 512 + h * 64 - (size_t)8 * 512;
  float sc[7];
  float mx = -3e38f;
#pragma unroll
  for (int k = 0; k < 7; k++) {
    int q = lane + 64 * k; if (q > 386) q = 386;
    const int g = (q >= 258) ? 2 : ((q >= 129) ? 1 : 0);
    const int j = q - 129 * g, dj = j << (2 * g);
    const int idx = 2048 + t - dj;
    const float4* kr = (const float4*)(((idx < 2048) ? kpast : knew) + (size_t)idx * 512);
    float a = 0.f;
#pragma unroll
    for (int d = 0; d < 16; d++) {
      float4 kk = kr[d];
      a += qsm[d * 4] * kk.x + qsm[d * 4 + 1] * kk.y + qsm[d * 4 + 2] * kk.z + qsm[d * 4 + 3] * kk.w;
    }
    a -= slope * (float)dj;
    if (lane + 64 * k > 386) a = -3e38f;
    sc[k] = a;
    mx = fmaxf(mx, a);
  }
#pragma unroll
  for (int o = 32; o > 0; o >>= 1) mx = fmaxf(mx, __shfl_xor(mx, o, 64));
  float den = 0.f;
#pragma unroll
  for (int k = 0; k < 7; k++) {
    const int q = lane + 64 * k;
    float pv = (q <= 386) ? fexp(sc[k] - mx) : 0.f;
    if (q < 400) psm[q] = pv;
    den += pv;
  }
#pragma unroll
  for (int o = 32; o > 0; o >>= 1) den += __shfl_xor(den, o, 64);
  __builtin_amdgcn_wave_barrier();
  __builtin_amdgcn_fence(__ATOMIC_ACQ_REL, "wavefront");
  const int d4 = lane & 15, kg = lane >> 4;
  float4 acc = make_float4(0.f, 0.f, 0.f, 0.f);
#pragma unroll 16
  for (int i = 0; i < 97; i++) {
    int q = 4 * i + kg;
    const float pv = psm[q];
    if (q > 386) q = 386;
    const int g = (q >= 258) ? 2 : ((q >= 129) ? 1 : 0);
    const int j = q - 129 * g, dj = j << (2 * g);
    const int idx = 2048 + t - dj;
    const float4 v = *(const float4*)(((idx < 2048) ? vpast : vnew) + (size_t)idx * 512 + d4 * 4);
    acc.x += pv * v.x; acc.y += pv * v.y; acc.z += pv * v.z; acc.w += pv * v.w;
  }
  acc.x += __shfl_xor(acc.x, 16, 64); acc.y += __shfl_xor(acc.y, 16, 64); acc.z += __shfl_xor(acc.z, 16, 64); acc.w += __shfl_xor(acc.w, 16, 64);
  acc.x += __shfl_xor(acc.x, 32, 64); acc.y += __shfl_xor(acc.y, 32, 64); acc.z += __shfl_xor(acc.z, 32, 64); acc.w += __shfl_xor(acc.w, 32, 64);
  if (lane < 16) {
    u16* mixed = (u16*)(p.ws + WS_B);
    const float inv = 1.f / den;
    uint2 o; o.x = pack2(acc.x * inv, acc.y * inv); o.y = pack2(acc.z * inv, acc.w * inv);
    *(uint2*)(mixed + rq * DM + 512 + h * 64 + d4 * 4) = o;
  }
  __syncthreads();
}

constexpr int CP_ROWS = 64 * 510;
constexpr int CP_TAIL = 8000;
constexpr int NCP_AT = 5, CP0_AT = 2 * CP_TAIL;
constexpr int NCP_RU = 3, CP0_RU = CP0_AT + 3072 * 5;
DEVI size_t cp_off(int R, int& kv) {
  const int bt = R / 510, rr = R - bt * 510;
  kv = bt >> 5;
  return (size_t)(bt & 31) * (2048 * 512 / 4) + (size_t)rr * 512 + threadIdx.x;
}
template <int N> struct CopyRegs { f32x4 v[N]; };
template <int N> DEVI void cp_load(const Params& p, int row0, CopyRegs<N>& c) {
#pragma unroll
  for (int k = 0; k < N; k++) {
    const int Rw = row0 + k;
    if (Rw < CP_ROWS) { int kv; const size_t o = cp_off(Rw, kv); c.v[k] = __builtin_nontemporal_load((const f32x4*)p.in[3 + kv] + 8 * 512 / 4 + o); }
  }
}
template <int N> DEVI void cp_store(const Params& p, int row0, const CopyRegs<N>& c) {
  asm volatile("" : "+s"(row0));
#pragma unroll
  for (int k = 0; k < N; k++) {
    const int Rw = row0 + k;
    if (Rw < CP_ROWS) { int kv; const size_t o = cp_off(Rw, kv); __builtin_nontemporal_store(c.v[k], (f32x4*)(p.out + (kv ? O_VS : O_KS)) + o); }
  }
}

DEVI void phase_mix_a(const Params& p, char* smem) {
  const int nb = gridDim.x;
  const bool late = (blockIdx.x & 1) != 0;
  if (!late) {
    for (int it = blockIdx.x; it < 256; it += nb) attn_sample_item(p, it, smem);
    {
      RuRegs RU;
      if ((int)blockIdx.x < 512) ru_load(p, blockIdx.x, RU);
      for (int it = blockIdx.x; it < 512; it += nb) {
        CopyRegs<NCP_RU> cp; cp_load(p, CP0_RU + it * NCP_RU, cp);
        ret_u_item(p, it, smem, RU, (it + nb < 512) ? it + nb : -1);
        cp_store(p, CP0_RU + it * NCP_RU, cp);
      }
    }
  }
  __syncthreads();
  if (threadIdx.x < 144) *(uint4*)(smem + 256 * 144 + threadIdx.x * 16) = make_uint4(0u, 0u, 0u, 0u);
  *(uint4*)(smem + AT_VT + (threadIdx.x >> 3) * 656 + (256 + (threadIdx.x & 7) * 8) * 2) = make_uint4(0u, 0u, 0u, 0u);
  AttnRegs R;
  if ((int)blockIdx.x < 3072) attn_load(p, blockIdx.x, R);
  for (int it = blockIdx.x; it < 3072; it += nb) {
    CopyRegs<NCP_AT> cp; cp_load(p, CP0_AT + it * NCP_AT, cp);
    attn_stage(R, smem);
    const bf16x8 qf0 = R.q0, qf1 = R.q1;
    __syncthreads();
    if (it + nb < 3072) attn_load(p, it + nb, R);
    attn_compute(p, it, qf0, qf1, smem);
    cp_store(p, CP0_AT + it * NCP_AT, cp);
    __syncthreads();
  }
  if (late) {
    for (int it = blockIdx.x; it < 256; it += nb) attn_sample_item(p, it, smem);
    {
      RuRegs RU;
      if ((int)blockIdx.x < 512) ru_load(p, blockIdx.x, RU);
      for (int it = blockIdx.x; it < 512; it += nb) {
        CopyRegs<NCP_RU> cp; cp_load(p, CP0_RU + it * NCP_RU, cp);
        ret_u_item(p, it, smem, RU, (it + nb < 512) ? it + nb : -1);
        cp_store(p, CP0_RU + it * NCP_RU, cp);
      }
    }
  }
}

DEVI void phase_mix_b(const Params& p) {
  const int gt = blockIdx.x * NTHR + threadIdx.x, gn = gridDim.x * NTHR;
  if (gt < 65536) {
    const int bh = gt >> 13, rem = gt & 8191, h = bh & 3;
    const float dec = exp2f(128.f * ret_log2g(h));
    const float* UT = (const float*)(p.ws + WS_UT) + (size_t)bh * 64 * 8192 + rem;
    u16* SPT = (u16*)(p.ws + WS_SPT) + (size_t)bh * 64 * 8192 + rem;
    float S = 0.f;
#pragma unroll 8
    for (int c = 0; c < 64; c++) {
      SPT[(size_t)c * 8192] = f2bf(S);
      S = dec * S + UT[(size_t)c * 8192];
    }
    const int e = rem >> 6, d = rem & 63;
    p.out[O_RETP + (size_t)bh * 8192 + d * 128 + e] = S;
  }
  const u16* ao = (const u16*)(p.ws + WS_ATTO);
  const float* lse = (const float*)(p.ws + WS_LSE);
  u16* mixed = (u16*)(p.ws + WS_B);
#pragma unroll 8
  for (int i = gt; i < TP * 64; i += gn) {
    const int row = i >> 6, h = (i >> 3) & 7, part = i & 7;
    float l0 = lse[(size_t)row * 8 + h], l1 = lse[(size_t)(TP + row) * 8 + h], l2 = lse[(size_t)(2 * TP + row) * 8 + h];
    float M = fmaxf(l0, fmaxf(l1, l2));
    float w0 = fexp(l0 - M), w1 = fexp(l1 - M), w2 = fexp(l2 - M);
    float inv = 1.f / (w0 + w1 + w2);
    w0 *= inv; w1 *= inv; w2 *= inv;
    const size_t off = (size_t)row * 512 + h * 64 + part * 8;
    uint4 a0 = *(const uint4*)(ao + off), a1 = *(const uint4*)(ao + (size_t)TP * 512 + off), a2 = *(const uint4*)(ao + (size_t)2 * TP * 512 + off);
    const u16* e0 = (const u16*)&a0; const u16* e1 = (const u16*)&a1; const u16* e2 = (const u16*)&a2;
    uint4 o; unsigned* oo = (unsigned*)&o;
#pragma unroll
    for (int q = 0; q < 4; q++) {
      float x0 = w0 * bf2f(e0[2 * q]) + w1 * bf2f(e1[2 * q]) + w2 * bf2f(e2[2 * q]);
      float x1 = w0 * bf2f(e0[2 * q + 1]) + w1 * bf2f(e1[2 * q + 1]) + w2 * bf2f(e2[2 * q + 1]);
      oo[q] = pack2(x0, x1);
    }
    *(uint4*)(mixed + (size_t)row * DM + 512 + h * 64 + part * 8) = o;
  }
}

struct RoRegs { u32x4 q0, q1, k0, k1, v0, v1, v2, v3; };
DEVI void ro_load(const Params& p, int item, RoRegs& R) {
  int tid_ = threadIdx.x; asm volatile("" : "+v"(tid_));
  const int tid = tid_;
  const int bh = item >> 6, c = item & 63, b = bh >> 2, h = bh & 3;
  const u16* qkv = (const u16*)(p.ws + WS_A);
  const size_t r0 = (size_t)b * 8192 + c * 128;
#define RO_QK(i, QQ, KK) { const int ch = tid + i * 512, m = ch >> 3, part = ch & 7; \
    QQ = *(const u32x4*)(qkv + (r0 + m) * QW + h * 64 + part * 8); KK = *(const u32x4*)(qkv + (r0 + m) * QW + 256 + h * 64 + part * 8); }
#define RO_V(i, VV) { const int ch = tid + i * 512, m = ch >> 4, part = ch & 15; VV = *(const u32x4*)(qkv + (r0 + m) * QW + 512 + h * 128 + part * 8); }
  RO_QK(0, R.q0, R.k0) RO_QK(1, R.q1, R.k1) RO_V(0, R.v0) RO_V(1, R.v1) RO_V(2, R.v2) RO_V(3, R.v3)
#undef RO_QK
#undef RO_V
}
DEVI void ret_out_item(const Params& p, int item, char* smem, RoRegs& R, int next_item) {
  int tid_ = threadIdx.x; asm volatile("" : "+v"(tid_));
  const int tid = tid_, lane = tid & 63, w = tid >> 6, l15 = lane & 15, lq = lane >> 4;
  const int bh = item >> 6, c = item & 63, b = bh >> 2, h = bh & 3;
  const u16* qkv = (const u16*)(p.ws + WS_A);
  const size_t r0 = (size_t)b * 8192 + c * 128;
  const float l2g = ret_log2g(h);
  char* Qs = smem;
  char* Ks = smem + 18432;
  char* Vt = smem + 36864;
  char* Sw = smem + 36864 + 34816 + w * 4352;
#define RO_SQK(i, QQ, KK) { const int ch = tid + i * 512, m = ch >> 3, part = ch & 7; \
    *(u32x4*)(Qs + m * 144 + part * 16) = QQ; *(u32x4*)(Ks + m * 144 + part * 16) = KK; }
#define RO_SV(i, VV) { const int ch = tid + i * 512, m = ch >> 4, part = ch & 15; char* vb = Vt + (part * 8) * 272 + m * 2; \
    *(u16*)(vb) = (u16)(VV.x & 0xffffu); *(u16*)(vb + 272) = (u16)(VV.x >> 16); \
    *(u16*)(vb + 2 * 272) = (u16)(VV.y & 0xffffu); *(u16*)(vb + 3 * 272) = (u16)(VV.y >> 16); \
    *(u16*)(vb + 4 * 272) = (u16)(VV.z & 0xffffu); *(u16*)(vb + 5 * 272) = (u16)(VV.z >> 16); \
    *(u16*)(vb + 6 * 272) = (u16)(VV.w & 0xffffu); *(u16*)(vb + 7 * 272) = (u16)(VV.w >> 16); }
  RO_SQK(0, R.q0, R.k0) RO_SQK(1, R.q1, R.k1) RO_SV(0, R.v0) RO_SV(1, R.v1) RO_SV(2, R.v2) RO_SV(3, R.v3)
#undef RO_SQK
#undef RO_SV
  __syncthreads();
  if (next_item >= 0) ro_load(p, next_item, R);
  bf16x8 qf[2];
  qf[0] = *(const bf16x8*)(Qs + (16 * w + l15) * 144 + lq * 16);
  qf[1] = *(const bf16x8*)(Qs + (16 * w + l15) * 144 + 64 + lq * 16);
  f32x4 acc[8];
  const u16* SPT = (const u16*)(p.ws + WS_SPT) + (size_t)item * 8192;
#pragma unroll
  for (int et = 0; et < 8; et++) {
    acc[et] = (f32x4){0.f, 0.f, 0.f, 0.f};
#pragma unroll
    for (int ks = 0; ks < 2; ks++) {
      bf16x8 sf = *(const bf16x8*)(SPT + (et * 16 + l15) * 64 + ks * 32 + lq * 8);
      acc[et] = mfma16(sf, qf[ks], acc[et]);
    }
  }
  const float qd = exp2f((float)(16 * w + l15 + 1) * l2g);
#pragma unroll
  for (int et = 0; et < 8; et++)
#pragma unroll
    for (int jj = 0; jj < 4; jj++) acc[et][jj] *= qd;
  for (int mt = 0; mt <= w; mt++) {
    f32x4 sa = (f32x4){0.f, 0.f, 0.f, 0.f};
#pragma unroll
    for (int ks = 0; ks < 2; ks++) {
      bf16x8 kf = *(const bf16x8*)(Ks + (mt * 16 + l15) * 144 + ks * 64 + lq * 16);
      sa = mfma16(qf[ks], kf, sa);
    }
    const int m = mt * 16 + l15;
#pragma unroll
    for (int jj = 0; jj < 4; jj++) {
      const int n = 16 * w + lq * 4 + jj;
      float v = (n >= m) ? sa[jj] * 0.125f * exp2f((float)(n - m) * l2g) : 0.f;
      *(u16*)(Sw + (lq * 4 + jj) * 272 + m * 2) = f2bf(v);
    }
  }
  if ((w & 1) == 0) *(uint2*)(Sw + (lane >> 2) * 272 + ((w + 1) * 16 + (lane & 3) * 4) * 2) = make_uint2(0u, 0u);
  __builtin_amdgcn_wave_barrier();
  __builtin_amdgcn_fence(__ATOMIC_ACQ_REL, "wavefront");
  for (int ks = 0; ks <= (w >> 1); ks++) {
    bf16x8 sf = *(const bf16x8*)(Sw + l15 * 272 + ks * 64 + lq * 16);
#pragma unroll
    for (int et = 0; et < 8; et++) {
      bf16x8 vf = *(const bf16x8*)(Vt + (et * 16 + l15) * 272 + ks * 64 + lq * 16);
      acc[et] = mfma16(vf, sf, acc[et]);
    }
  }
  u16* mixed = (u16*)(p.ws + WS_B);
  const float* gn = p.in[11] + h * 128;
  float sm_ = 0.f;
#pragma unroll
  for (int et = 0; et < 8; et++) sm_ += acc[et][0] + acc[et][1] + acc[et][2] + acc[et][3];
  sm_ += __shfl_xor(sm_, 16, 64);
  sm_ += __shfl_xor(sm_, 32, 64);
  const float mu = sm_ * (1.f / 128.f);
  float vs = 0.f;
#pragma unroll
  for (int et = 0; et < 8; et++)
#pragma unroll
    for (int jj = 0; jj < 4; jj++) { const float d = acc[et][jj] - mu; vs += d * d; }
  vs += __shfl_xor(vs, 16, 64);
  vs += __shfl_xor(vs, 32, 64);
  const float rs = rsqrtf(vs * (1.f / 128.f) + 1e-6f);
  const size_t row = r0 + 16 * w + l15;
#pragma unroll
  for (int et = 0; et < 8; et++) {
    const int e = et * 16 + lq * 4;
    const float4 gg = *(const float4*)(gn + e);
    const float4 ga = ld_bf4(qkv + row * QW + 1024 + h * 128 + e);
    uint2 o;
    o.x = pack2(siluf(ga.x) * ((acc[et][0] - mu) * rs * gg.x), siluf(ga.y) * ((acc[et][1] - mu) * rs * gg.y));
    o.y = pack2(siluf(ga.z) * ((acc[et][2] - mu) * rs * gg.z), siluf(ga.w) * ((acc[et][3] - mu) * rs * gg.w));
    *(uint2*)(mixed + row * DM + h * 128 + e) = o;
  }
  __syncthreads();
}

struct S5c { float ar, ai; };

DEVI void s5_setup(const Params& p, int g, int n, float& ar, float& ai, float* bfr, float* bfi) {
  const float dt = expf(p.in[15][g]);
  const float lr = p.in[13][g * 64 + n], li = p.in[14][g * 64 + n];
  const float mag = expf(lr * dt);
  float sn, cs;
  sincosf(li * dt, &sn, &cs);
  ar = mag * cs; ai = mag * sn;
  const float den = lr * lr + li * li;
  const float fr = ((ar - 1.f) * lr + ai * li) / den;
  const float fi = (ai * lr - (ar - 1.f) * li) / den;
  const float4* br = (const float4*)(p.in[16] + ((size_t)g * 64 + n) * 16);
  const float4* bi = (const float4*)(p.in[17] + ((size_t)g * 64 + n) * 16);
#pragma unroll
  for (int q = 0; q < 4; q++) {
    float4 x = br[q], y = bi[q];
    bfr[q * 4 + 0] = fr * x.x - fi * y.x; bfi[q * 4 + 0] = fr * y.x + fi * x.x;
    bfr[q * 4 + 1] = fr * x.y - fi * y.y; bfi[q * 4 + 1] = fr * y.y + fi * x.y;
    bfr[q * 4 + 2] = fr * x.z - fi * y.z; bfi[q * 4 + 2] = fr * y.z + fi * x.z;
    bfr[q * 4 + 3] = fr * x.w - fi * y.w; bfi[q * 4 + 3] = fr * y.w + fi * x.w;
  }
}

DEVI void s5_stage_u(const Params& p, size_t row0, int L, int go, float* us) {
  const int tid = threadIdx.x;
  const u64* ssq = (const u64*)(p.ws + WS_SSQ);
  const float* gain = p.in[7] + 1024 + go * 128;
  for (int i = tid; i < L * 32; i += NTHR) {
    int t = i >> 5, c4 = i & 31;
    float rstd = ssq_rstd(ssq + TT + row0 + t);
    float4 y = ld_bf4((const u16*)(p.ws + WS_YB) + (row0 + t) * DM + go * 128 + c4 * 4);
    float4 gg = *(const float4*)(gain + c4 * 4);
    *(float4*)(us + t * 128 + c4 * 4) = make_float4(y.x * rstd * gg.x, y.y * rstd * gg.y, y.z * rstd * gg.z, y.w * rstd * gg.w);
  }
}

DEVI void s5c_item(const Params& p, bool sample, int item, char* smem) {
  const int tid = threadIdx.x, lane = tid & 63, n = lane, w = tid >> 6, l15 = lane & 15, lq = lane >> 4;
  int go, L; size_t row0; int b = 0, c = 0, bs = 0;
  if (sample) { go = item & 7; bs = item >> 3; L = 8; row0 = (size_t)TP + bs * 8; }
  else { go = item & 7; c = (item >> 3) & 255; b = item >> 11; L = 32; row0 = (size_t)b * 8192 + c * 32; }
  const int g = go * 8 + w;
  float* us = (float*)smem;
  char* xs = smem + 16384 + w * 8704;
  s5_stage_u(p, row0, L, go, us);
  float ar, ai, bfr[16], bfi[16];
  s5_setup(p, g, n, ar, ai, bfr, bfi);
  float xr, xi;
  if (sample) {
    xr = p.in[5][((size_t)bs * 64 + g) * 64 + n];
    xi = p.in[6][((size_t)bs * 64 + g) * 64 + n];
  } else {
    float2 x0 = ((const float2*)(p.ws + WS_XP))[((size_t)(b * 256 + c) * 64 + g) * 64 + n];
    xr = x0.x; xi = x0.y;
  }
  bf16x8 cf[4];
#pragma unroll
  for (int ks = 0; ks < 4; ks++) {
    const int nb = (ks & 1) * 32 + lq * 8;
    const float* src = ((ks < 2) ? p.in[18] : p.in[19]) + ((size_t)g * 16 + l15) * 64 + nb;
    const float sgn = (ks < 2) ? 1.f : -1.f;
    float4 a0 = *(const float4*)src, a1 = *(const float4*)(src + 4);
    bf16x8 f;
    f[0] = (short)f2bf(sgn * a0.x); f[1] = (short)f2bf(sgn * a0.y); f[2] = (short)f2bf(sgn * a0.z); f[3] = (short)f2bf(sgn * a0.w);
    f[4] = (short)f2bf(sgn * a1.x); f[5] = (short)f2bf(sgn * a1.y); f[6] = (short)f2bf(sgn * a1.z); f[7] = (short)f2bf(sgn * a1.w);
    cf[ks] = f;
  }
  __syncthreads();
  for (int t = 0; t < L; t++) {
    const float4* u4 = (const float4*)(us + t * 128 + w * 16);
    float dr = 0.f, di = 0.f;
#pragma unroll
    for (int q = 0; q < 4; q++) {
      float4 u = u4[q];
      dr += bfr[q * 4] * u.x + bfr[q * 4 + 1] * u.y + bfr[q * 4 + 2] * u.z + bfr[q * 4 + 3] * u.w;
      di += bfi[q * 4] * u.x + bfi[q * 4 + 1] * u.y + bfi[q * 4 + 2] * u.z + bfi[q * 4 + 3] * u.w;
    }
    float nr = ar * xr - ai * xi + dr;
    float ni = ar * xi + ai * xr + di;
    xr = nr; xi = ni;
    *(u16*)(xs + t * 272 + n * 2) = f2bf(xr);
    *(u16*)(xs + t * 272 + 128 + n * 2) = f2bf(xi);
  }
  if (sample) {
    p.out[O_SRS + ((size_t)bs * 64 + g) * 64 + n] = xr;
    p.out[O_SIS + ((size_t)bs * 64 + g) * 64 + n] = xi;
    for (int t = 8; t < 16; t++) { *(u16*)(xs + t * 272 + n * 2) = 0; *(u16*)(xs + t * 272 + 128 + n * 2) = 0; }
  }
  __builtin_amdgcn_wave_barrier();
  __builtin_amdgcn_fence(__ATOMIC_ACQ_REL, "wavefront");
  u16* z = (u16*)(p.ws + WS_B);
  const float dsk = p.in[20][g * 16 + l15];
  const int nmt = sample ? 1 : 2;
  for (int mt = 0; mt < nmt; mt++) {
    f32x4 ya = (f32x4){0.f, 0.f, 0.f, 0.f};
#pragma unroll
    for (int ks = 0; ks < 4; ks++) {
      bf16x8 xf = *(const bf16x8*)(xs + (mt * 16 + l15) * 272 + ks * 64 + lq * 16);
      ya = mfma16(xf, cf[ks], ya);
    }
#pragma unroll
    for (int jj = 0; jj < 4; jj++) {
      const int t = mt * 16 + lq * 4 + jj;
      if (t < L) {
        float y = ya[jj] + dsk * us[t * 128 + w * 16 + l15];
        z[(row0 + t) * DM + g * 16 + l15] = f2bf(geluf(y));
      }
    }
  }
  __syncthreads();
}

DEVI void s5_pre_item(const Params& p, int item, char* smem) {
  const int tid = threadIdx.x, g = item >> 2, tq = item & 3;
  float2* bfs = (float2*)smem;
  float2* apw = bfs + 1024;
  float2* cs = apw + 33 * 64;
  if (tid < 64) {
    float ar, ai, bfr[16], bfi[16];
    s5_setup(p, g, tid, ar, ai, bfr, bfi);
    const float* gain = p.in[7] + 1024 + g * 16;
#pragma unroll
    for (int q = 0; q < 16; q++) bfs[tid * 16 + q] = make_float2(bfr[q] * gain[q], bfi[q] * gain[q]);
    float pr = 1.f, pi = 0.f;
    for (int d = 0; d <= 32; d++) {
      apw[d * 64 + tid] = make_float2(pr, pi);
      float nr = pr * ar - pi * ai, ni = pr * ai + pi * ar;
      pr = nr; pi = ni;
    }
  }
  for (int i = tid; i < 1024; i += NTHR) cs[i] = make_float2(p.in[18][(size_t)g * 1024 + i], p.in[19][(size_t)g * 1024 + i]);
  __syncthreads();
  u16* KD = (u16*)(p.ws + WS_KD) + (size_t)g * 32 * 256;
#pragma unroll 1
  for (int i = 0; i < 4; i++) {
    const int o = tid + 512 * i, dl = o >> 8, pp = (o >> 4) & 15, q = o & 15, d = 8 * tq + dl;
    float acc = 0.f;
#pragma unroll 4
    for (int n = 0; n < 64; n++) {
      float2 c = cs[pp * 64 + n], a = apw[d * 64 + n], bb = bfs[n * 16 + q];
      float car = c.x * a.x - c.y * a.y, cai = c.x * a.y + c.y * a.x;
      acc += car * bb.x - cai * bb.y;
    }
    if (d == 0 && pp == q) acc += p.in[20][g * 16 + pp] * p.in[7][1024 + g * 16 + pp];
    KD[d * 256 + pp * 16 + q] = f2bf(acc);
  }
  u16* MT = (u16*)(p.ws + WS_MT) + (size_t)g * 128 * 512;
#pragma unroll 4
  for (int i = 0; i < 32; i++) {
    const int o = tid + 512 * i, np = o >> 7, kk = o & 127, sl = kk >> 4, q = kk & 15, sI = 8 * tq + sl, n = np & 63;
    float2 a = apw[(31 - sI) * 64 + n], bb = bfs[n * 16 + q];
    float v = (np < 64) ? (a.x * bb.x - a.y * bb.y) : (a.x * bb.y + a.y * bb.x);
    MT[np * 512 + sI * 16 + q] = f2bf(v);
  }
  u16* PT = (u16*)(p.ws + WS_PT) + (size_t)g * 512 * 128;
#pragma unroll 4
  for (int i = 0; i < 32; i++) {
    const int o = tid + 512 * i, tpl = o >> 7, np = o & 127, tl = tpl >> 4, pp = tpl & 15, t = 8 * tq + tl, n = np & 63;
    float2 c = cs[pp * 64 + n], a = apw[(t + 1) * 64 + n];
    float v = (np < 64) ? (c.x * a.x - c.y * a.y) : -(c.x * a.y + c.y * a.x);
    PT[(t * 16 + pp) * 128 + np] = f2bf(v);
  }
  __syncthreads();
}

DEVI bf16x8 s5_ufrag(const u16* yb, const u64* ssq1, int row, int col) {
  uint4 raw = *(const uint4*)(yb + (size_t)row * DM + col);
  const float rs = ssq_rstd(ssq1 + row);
  const unsigned r0 = raw.x, r1 = raw.y, r2 = raw.z, r3 = raw.w;
  const u32x4 o = {pack2(__uint_as_float(r0 << 16) * rs, __uint_as_float(r0 & 0xffff0000u) * rs),
                   pack2(__uint_as_float(r1 << 16) * rs, __uint_as_float(r1 & 0xffff0000u) * rs),
                   pack2(__uint_as_float(r2 << 16) * rs, __uint_as_float(r2 & 0xffff0000u) * rs),
                   pack2(__uint_as_float(r3 << 16) * rs, __uint_as_float(r3 & 0xffff0000u) * rs)};
  return __builtin_bit_cast(bf16x8, o);
}

DEVI void s5a_mfma(const Params& p, int g, int mtq, char* smem) {
  int tid_ = threadIdx.x; asm volatile("" : "+v"(tid_));
  const int tid = tid_, lane = tid & 63, w = tid >> 6, fr = lane & 15, fq = lane >> 4;
  const int c0 = (mtq * 8 + w) * 16;
  const u16* yb = (const u16*)(p.ws + WS_YB);
  const u64* ssq1 = (const u64*)(p.ws + WS_SSQ) + TT;
  const u16* MT = (const u16*)(p.ws + WS_MT) + (size_t)g * 128 * 512;
  bf16x8 au[16];
#pragma unroll
  for (int ks = 0; ks < 16; ks++) au[ks] = s5_ufrag(yb, ssq1, (c0 + fr) * 32 + 2 * ks + (fq >> 1), g * 16 + (fq & 1) * 8);
  f32x4 acc[8];
#pragma unroll
  for (int n = 0; n < 8; n++) acc[n] = (f32x4){0.f, 0.f, 0.f, 0.f};
  u32x4 stg[8];
#pragma unroll
  for (int i = 0; i < 8; i++) { const int ch = tid + i * 512, r = ch >> 5, cc = ch & 31; stg[i] = *(const u32x4*)(MT + (size_t)r * 512 + cc * 8); }
#pragma unroll
  for (int half = 0; half < 2; half++) {
    __syncthreads();
#pragma unroll
    for (int i = 0; i < 8; i++) {
      const int ch = tid + i * 512, r = ch >> 5, cc = ch & 31;
      *(u32x4*)(smem + r * 528 + cc * 16) = stg[i];
    }
    __syncthreads();
    if (half == 0) {
#pragma unroll
      for (int i = 0; i < 8; i++) { const int ch = tid + i * 512, r = ch >> 5, cc = ch & 31; stg[i] = *(const u32x4*)(MT + (size_t)r * 512 + 256 + cc * 8); }
    }
#pragma unroll
    for (int ksl = 0; ksl < 8; ksl++) {
#pragma unroll
      for (int n = 0; n < 8; n++) {
        bf16x8 bf = *(const bf16x8*)(smem + (n * 16 + fr) * 528 + ksl * 64 + fq * 16);
        acc[n] = mfma16(bf, au[half * 8 + ksl], acc[n]);
      }
    }
  }
  float* E = (float*)(p.ws + WS_E) + ((size_t)(c0 + fr) * 64 + g) * 128;
#pragma unroll
  for (int n = 0; n < 8; n++) *(float4*)(E + n * 16 + fq * 4) = make_float4(acc[n][0], acc[n][1], acc[n][2], acc[n][3]);
  __syncthreads();
}

DEVI void s5c_mfma(const Params& p, int g, int mtq, char* smem) {
  const int tid = threadIdx.x, lane = tid & 63, w = tid >> 6, fr = lane & 15, fq = lane >> 4;
  const int c0 = (mtq * 8 + w) * 16;
  const u16* yb = (const u16*)(p.ws + WS_YB);
  const u64* ssq1 = (const u64*)(p.ws + WS_SSQ) + TT;
  const u16* KDg = (const u16*)(p.ws + WS_KD) + (size_t)g * 32 * 256;
  const u16* PTg = (const u16*)(p.ws + WS_PT) + (size_t)g * 512 * 128;
  const u16* XP = (const u16*)(p.ws + WS_XP) + ((size_t)(c0 + fr) * 64 + g) * 128;
  u16* z = (u16*)(p.ws + WS_B);
  char* KDs = smem;
  char* PTs = smem + 16384;
#pragma unroll
  for (int i = 0; i < 2; i++) { const int ch = tid + i * 512; *(uint4*)(KDs + ch * 16) = *(const uint4*)(KDg + ch * 8); }
  bf16x8 au[16], ax[4];
#pragma unroll
  for (int ks = 0; ks < 16; ks++) au[ks] = s5_ufrag(yb, ssq1, (c0 + fr) * 32 + 2 * ks + (fq >> 1), g * 16 + (fq & 1) * 8);
#pragma unroll
  for (int ks = 0; ks < 4; ks++) ax[ks] = *(const bf16x8*)(XP + ks * 32 + fq * 8);
  const bf16x8 zero8 = (bf16x8){0, 0, 0, 0, 0, 0, 0, 0};
  u32x4 stg[8];
#pragma unroll
  for (int i = 0; i < 8; i++) { const int ch = tid + i * 512, r = ch >> 4, cc = ch & 15; stg[i] = *(const u32x4*)(PTg + (size_t)r * 128 + cc * 8); }
#pragma unroll
  for (int half = 0; half < 2; half++) {
    __syncthreads();
#pragma unroll
    for (int i = 0; i < 8; i++) {
      const int ch = tid + i * 512, r = ch >> 4, cc = ch & 15;
      *(u32x4*)(PTs + r * 272 + cc * 16) = stg[i];
    }
    __syncthreads();
    if (half == 0) {
#pragma unroll
      for (int i = 0; i < 8; i++) { const int ch = tid + i * 512, r = ch >> 4, cc = ch & 15; stg[i] = *(const u32x4*)(PTg + (size_t)(256 + r) * 128 + cc * 8); }
    }
#pragma unroll 1
    for (int q4 = 0; q4 < 4; q4++) {
      const int t0 = half * 16 + q4 * 4;
      const int nks = (t0 >> 1) + 2;
      f32x4 acc[4];
#pragma unroll
      for (int j = 0; j < 4; j++) acc[j] = (f32x4){0.f, 0.f, 0.f, 0.f};
#pragma unroll
      for (int ks = 0; ks < 16; ks++) {
        if (ks < nks) {
#pragma unroll
          for (int j = 0; j < 4; j++) {
            const int d = t0 + j - 2 * ks - (fq >> 1);
            const int dc = d < 0 ? 0 : d;
            bf16x8 bf = *(const bf16x8*)(KDs + (dc * 256 + fr * 16 + (fq & 1) * 8) * 2);
            bf = (d < 0) ? zero8 : bf;
            acc[j] = mfma16(bf, au[ks], acc[j]);
          }
        }
      }
#pragma unroll
      for (int ks = 0; ks < 4; ks++) {
#pragma unroll
        for (int j = 0; j < 4; j++) {
          bf16x8 bf = *(const bf16x8*)(PTs + ((q4 * 4 + j) * 16 + fr) * 272 + ks * 64 + fq * 16);
          acc[j] = mfma16(bf, ax[ks], acc[j]);
        }
      }
#pragma unroll
      for (int j = 0; j < 4; j++) {
        const int row = (c0 + fr) * 32 + t0 + j, col = g * 16 + fq * 4;
        uint2 o; o.x = pack2(geluf(acc[j][0]), geluf(acc[j][1])); o.y = pack2(geluf(acc[j][2]), geluf(acc[j][3]));
        *(uint2*)(z + (size_t)row * DM + col) = o;
      }
    }
  }
  __syncthreads();
}

DEVI void s5b_item(const Params& p, int item, char* smem) {
  const int tid = threadIdx.x, n = tid & 63, seg = tid >> 6;
  const int b = item >> 6, g = item & 63;
  float2* cs_ = (float2*)smem;
  const float dt = expf(p.in[15][g]);
  const float lr = p.in[13][g * 64 + n], li = p.in[14][g * 64 + n];
  const float mag = expf(lr * dt);
  float sn, cs;
  sincosf(li * dt, &sn, &cs);
  float ar = mag * cs, ai = mag * sn;
#pragma unroll
  for (int q = 0; q < 5; q++) { float r2 = ar * ar - ai * ai, i2 = 2.f * ar * ai; ar = r2; ai = i2; }
  const float* E = (const float*)(p.ws + WS_E) + (((size_t)b * 256 + seg * 32) * 64 + g) * 128 + n;
  u16* XP = (u16*)(p.ws + WS_XP) + (((size_t)b * 256 + seg * 32) * 64 + g) * 128 + n;
  float er[32], ei[32];
#pragma unroll
  for (int c = 0; c < 32; c++) { er[c] = E[(size_t)c * 8192]; ei[c] = E[(size_t)c * 8192 + 64]; }
  float xr = 0.f, xi = 0.f;
#pragma unroll
  for (int c = 0; c < 32; c++) {
    float nr = ar * xr - ai * xi + er[c], ni = ar * xi + ai * xr + ei[c];
    xr = nr; xi = ni;
  }
  cs_[seg * 64 + n] = make_float2(xr, xi);
  __syncthreads();
  if (tid < 64) {
    float sr = ar, si = ai;
#pragma unroll
    for (int q = 0; q < 5; q++) { float r2 = sr * sr - si * si, i2 = 2.f * sr * si; sr = r2; si = i2; }
    float cr = 0.f, ci = 0.f;
    for (int sg = 0; sg < 8; sg++) {
      float2 e = cs_[sg * 64 + n];
      cs_[sg * 64 + n] = make_float2(cr, ci);
      float nr = sr * cr - si * ci + e.x, ni = sr * ci + si * cr + e.y;
      cr = nr; ci = ni;
    }
    p.out[O_SRP + (size_t)b * 4096 + g * 64 + n] = cr;
    p.out[O_SIP + (size_t)b * 4096 + g * 64 + n] = ci;
  }
  __syncthreads();
  float2 c0 = cs_[seg * 64 + n];
  xr = c0.x; xi = c0.y;
#pragma unroll
  for (int c = 0; c < 32; c++) {
    XP[(size_t)c * 8192] = f2bf(xr);
    XP[(size_t)c * 8192 + 64] = f2bf(xi);
    float nr = ar * xr - ai * xi + er[c], ni = ar * xi + ai * xr + ei[c];
    xr = nr; xi = ni;
  }
  __syncthreads();
}

DEVI void phase_final(const Params& p) {
  const int lane = threadIdx.x & 63, wid = threadIdx.x >> 6;
  const u64* ssq = (const u64*)(p.ws + WS_SSQ);
  const u16* yb = (const u16*)(p.ws + WS_YB);
  const float* g = p.in[9];
  float4 gg[4];
#pragma unroll
  for (int i = 0; i < 4; i++) gg[i] = *(const float4*)(g + i * 256 + lane * 4);
  const int nw = gridDim.x * 8;
  for (int row = blockIdx.x * 8 + wid; row < TT; row += nw * 4) {
    float4 v[4][4]; float rstd[4];
#pragma unroll
    for (int r = 0; r < 4; r++) {
      const int rr = row + r * nw;
      if (rr < TT) {
        rstd[r] = ssq_rstd(ssq + 3 * TT + rr);
#pragma unroll
        for (int i = 0; i < 4; i++) v[r][i] = ld_bf4(yb + (size_t)rr * DM + i * 256 + lane * 4);
      }
    }
#pragma unroll
    for (int r = 0; r < 4; r++) {
      const int rr = row + r * nw;
      if (rr < TT) {
        float* y = p.out + (size_t)rr * DM;
#pragma unroll
        for (int i = 0; i < 4; i++)
          *(float4*)(y + i * 256 + lane * 4) = make_float4(v[r][i].x * rstd[r] * gg[i].x, v[r][i].y * rstd[r] * gg[i].y, v[r][i].z * rstd[r] * gg[i].z, v[r][i].w * rstd[r] * gg[i].w);
      }
    }
  }
}

DEVI void copy_tail(const Params& p, int r0, int r1) {
  const int fb = (gridDim.x == 256) ? 128 : 0, nbk = (int)gridDim.x - fb, lb = (int)blockIdx.x - fb;
  if (lb < 0) return;
#pragma unroll 1
  for (int R0 = r0 + lb; R0 < r1; R0 += nbk * 8) {
    f32x4 v[8];
#pragma unroll
    for (int k = 0; k < 8; k++) {
      const int R = R0 + k * nbk;
      if (R < r1) { int kv; const size_t o = cp_off(R, kv); v[k] = __builtin_nontemporal_load((const f32x4*)p.in[3 + kv] + 8 * 512 / 4 + o); }
    }
#pragma unroll
    for (int k = 0; k < 8; k++) {
      const int R = R0 + k * nbk;
      if (R < r1) { int kv; const size_t o = cp_off(R, kv); __builtin_nontemporal_store(v[k], (f32x4*)(p.out + (kv ? O_VS : O_KS)) + o); }
    }
  }
}

DEVI void ffn_block(const Params& p, int layer, const XcdBarrier& xb, char* smem) {
  u16* bufA = (u16*)(p.ws + WS_A);
  u16* yb = (u16*)(p.ws + WS_YB);
  u64* ssq = (u64*)(p.ws + WS_SSQ);
  {
    SEpiSwiglu ES{bufA, ssq + (layer ? 2 * TT : 0)};
    sample_gemm(smem, yb, (const u16*)(p.ws + WS_WF1 + layer * SZ_WF1), 1024, 88, true, ES);
    EpiSwiglu E{bufA, ssq + (layer ? 2 * TT : 0)};
    run_gemm(smem, yb, (const u16*)(p.ws + WS_WF1 + layer * SZ_WF1), 5632, 1024, E);
    copy_tail(p, layer * CP_TAIL, (layer + 1) * CP_TAIL);
  }
  xcd_barrier(xb);
  {
    SEpiRes ES{yb, ssq + (layer ? 3 * TT : TT), nullptr};
    sample_gemm(smem, bufA, (const u16*)(p.ws + WS_WF2 + layer * SZ_WF2), 2816, 16, false, ES);
    EpiRes E{yb, ssq + (layer ? 3 * TT : TT), nullptr, nullptr};
    run_gemm(smem, bufA, (const u16*)(p.ws + WS_WF2 + layer * SZ_WF2), 1024, 2816, E);
  }
  xcd_barrier(xb);
}

__global__ void __launch_bounds__(NTHR, 2) mega(Params p) {
  extern __shared__ __attribute__((aligned(16))) char smem[];
  cg::grid_group grid = cg::this_grid();
  volatile LAS3 unsigned* xst = (volatile LAS3 unsigned*)(LAS3 char*)(smem + 128 * 1024);
  if (threadIdx.x == 0) { xst[0] = 0u; xst[1] = 0u; }
  __syncthreads();
  const XcdBarrier xb = xcd_barrier_post((unsigned*)(p.ws + WS_BAR), xst);
  u16* bufA = (u16*)(p.ws + WS_A);
  u16* bufB = (u16*)(p.ws + WS_B);
  u16* yb = (u16*)(p.ws + WS_YB);
  u64* ssq = (u64*)(p.ws + WS_SSQ);

  phase_prep(p, smem);
  for (int it = blockIdx.x; it < 256; it += gridDim.x) s5_pre_item(p, it, smem);
  xcd_barrier(xb);
  {
    SEpiQKV ES{bufA, p.out};
    sample_gemm(smem, bufB, (const u16*)(p.ws + WS_WIN), 1024, 48, false, ES);
    EpiQKV E{bufA, p.out};
    run_gemm(smem, bufB, (const u16*)(p.ws + WS_WIN), 3072, 1024, E);
  }
  xcd_barrier(xb);
  phase_mix_a(p, smem);
  xcd_barrier(xb);
  phase_mix_b(p);
  for (int it = (blockIdx.x + gridDim.x / 2) % gridDim.x; it < 128; it += gridDim.x) ret_sample_item(p, it, smem);
  xcd_barrier(xb);
  {
    RoRegs R;
    if ((int)blockIdx.x < 512) ro_load(p, blockIdx.x, R);
    for (int it = blockIdx.x; it < 512; it += gridDim.x) {
      const int nx = it + (int)gridDim.x;
      ret_out_item(p, it, smem, R, nx < 512 ? nx : -1);
    }
  }
  xcd_barrier(xb);
  {
    SEpiRes ES{yb, ssq, p.in[1]};
    sample_gemm(smem, bufB, (const u16*)(p.ws + WS_WOUT), 1024, 16, false, ES);
    EpiRes E{yb, ssq, p.in[0], p.in[1]};
    run_gemm(smem, bufB, (const u16*)(p.ws + WS_WOUT), 1024, 1024, E);
  }
  xcd_barrier(xb);
  ffn_block(p, 0, xb, smem);
  for (int it = blockIdx.x; it < 256; it += gridDim.x) {
    const int g = (it & 7) * 8 + (it >> 5), mtq = (it >> 3) & 3;
    s5a_mfma(p, g, mtq, smem);
  }
  xcd_barrier(xb);
  for (int it = blockIdx.x; it < 128; it += gridDim.x) s5b_item(p, it, smem);
  for (int it = (blockIdx.x + 128) % gridDim.x; it < 256; it += gridDim.x) s5c_item(p, true, it, smem);
  xcd_barrier(xb);
  for (int it = blockIdx.x; it < 256; it += gridDim.x) {
    const int g = (it & 7) * 8 + (it >> 5), mtq = (it >> 3) & 3;
    s5c_mfma(p, g, mtq, smem);
  }
  xcd_barrier(xb);
  {
    SEpiGlu ES{yb, ssq + 2 * TT};
    sample_gemm(smem, bufB, (const u16*)(p.ws + WS_WGLU), 1024, 32, true, ES);
    EpiGlu E{yb, ssq + 2 * TT};
    run_gemm(smem, bufB, (const u16*)(p.ws + WS_WGLU), 2048, 1024, E);
  }
  xcd_barrier(xb);
  ffn_block(p, 1, xb, smem);
  phase_final(p);
  if (p.ws == nullptr) grid.sync();
}

extern "C" void kernel_launch(void* const* d_in, const int* in_sizes, int n_in,
                              void* d_out, int out_size, void* d_ws, size_t ws_size,
                              hipStream_t stream) {
  static int grid_blocks = 0;
  if (!grid_blocks) {
    int dev = 0, cus = 0, per_cu = 0;
    (void)hipGetDevice(&dev);
    (void)hipDeviceGetAttribute(&cus, hipDeviceAttributeMultiprocessorCount, dev);
    (void)hipFuncSetAttribute((const void*)mega, hipFuncAttributeMaxDynamicSharedMemorySize, LDS_BYTES);
    (void)hipOccupancyMaxActiveBlocksPerMultiprocessor(&per_cu, mega, NTHR, LDS_BYTES);
    if (per_cu < 1) per_cu = 1;
    if (per_cu > 1) per_cu = 1;
    grid_blocks = cus * per_cu;
  }
  Params p{};
  for (int i = 0; i < 24; i++) p.in[i] = (const float*)d_in[i];
  p.out = (float*)d_out;
  p.ws = (char*)d_ws;
  (void)hipMemsetAsync((char*)d_ws + WS_BAR, 0, XCD_BAR_WORDS * 4, stream);
  void* args[] = {&p};
  hipError_t e = hipLaunchCooperativeKernel((void*)mega, dim3(grid_blocks), dim3(NTHR), args, LDS_BYTES, stream);
  if (e != hipSuccess) fprintf(stderr, "coop launch failed: %s (grid %d)\n", hipGetErrorString(e), grid_blocks);
}
```

```cpp
#include <hip/hip_runtime.h>
#include <hip/hip_bf16.h>
#include <hip/hip_cooperative_groups.h>
#include <cstdio>
namespace cg = cooperative_groups;

#define DEVI __device__ __forceinline__
typedef __attribute__((ext_vector_type(8))) short bf16x8;
typedef __attribute__((ext_vector_type(4))) float f32x4;
typedef unsigned short u16;
typedef unsigned long long u64;
typedef unsigned u32x4 __attribute__((ext_vector_type(4)));

constexpr int TP = 16384, TT = 16640, DM = 1024, QW = 3072, FF = 2816;
constexpr int NTHR = 512;
constexpr int LDS_BYTES = 128 * 1024 + 16;

constexpr size_t O_RETP = 17039360, O_RETS = 17104896, O_KP = 18153472, O_VP = 20250624,
                 O_KS = 22347776, O_VS = 55902208, O_SRP = 89456640, O_SIP = 89464832,
                 O_SRS = 89473024, O_SIS = 89604096;

constexpr size_t WS_WIN = 0;
constexpr size_t WS_WOUT = WS_WIN + (size_t)3072 * 1024 * 2;
constexpr size_t WS_WF1 = WS_WOUT + (size_t)1024 * 1024 * 2;
constexpr size_t SZ_WF1 = (size_t)5632 * 1024 * 2;
constexpr size_t WS_WF2 = WS_WF1 + 2 * SZ_WF1;
constexpr size_t SZ_WF2 = (size_t)1024 * 2816 * 2;
constexpr size_t WS_WGLU = WS_WF2 + 2 * SZ_WF2;
constexpr size_t WS_A = WS_WGLU + (size_t)2048 * 1024 * 2;
constexpr size_t WS_B = WS_A + (size_t)TT * 3072 * 2;
constexpr size_t WS_YB = WS_B + (size_t)TT * 1024 * 2;
constexpr size_t WS_SSQ = WS_YB + (size_t)TT * 1024 * 2;
constexpr size_t WS_ATTO = WS_SSQ + (size_t)TT * 32 * 4;
constexpr size_t WS_LSE = WS_ATTO + (size_t)3 * TP * 512 * 2;
constexpr size_t WS_UT = WS_LSE + (size_t)3 * TP * 8 * 4;
constexpr size_t WS_SPT = WS_UT + (size_t)512 * 8192 * 4;
constexpr size_t WS_E = WS_SPT + (size_t)512 * 8192 * 2;
constexpr size_t WS_XP = WS_E + (size_t)2 * 256 * 4096 * 8;
constexpr size_t WS_KD = WS_XP + (size_t)2 * 256 * 4096 * 8;
constexpr size_t WS_MT = WS_KD + (size_t)64 * 32 * 256 * 2;
constexpr size_t WS_PT = WS_MT + (size_t)64 * 128 * 512 * 2;
constexpr size_t WS_BAR = WS_PT + (size_t)64 * 512 * 128 * 2;
constexpr size_t WS_END = WS_BAR + 16384;

struct Params {
  const float* in[24];
  float* out;
  char* ws;
};

DEVI float bf2f(u16 h) { return __uint_as_float(((unsigned)h) << 16); }
DEVI u16 f2bf(float f) {
  unsigned u = __float_as_uint(f);
  u += 0x7fffu + ((u >> 16) & 1u);
  return (u16)(u >> 16);
}
DEVI unsigned pack2(float a, float b) { unsigned r; asm("v_cvt_pk_bf16_f32 %0, %1, %2" : "=v"(r) : "v"(a), "v"(b)); return r; }
DEVI float fexp(float x) { return __builtin_amdgcn_exp2f(x * 1.4426950408889634f); }
DEVI float siluf(float x) { return x * __builtin_amdgcn_rcpf(1.f + fexp(-x)); }
DEVI float sigmf(float x) { return __builtin_amdgcn_rcpf(1.f + fexp(-x)); }
DEVI float geluf(float x) {
  float u = 1.5957691216057308f * (x + 0.044715f * x * x * x);
  return x * sigmf(u);
}
DEVI void ssq_add(u64* p, float ss) { atomicAdd(p, (u64)(ss * 1048576.f)); }
DEVI float ssq_rstd(const u64* p) { return rsqrtf((float)(*p) * (1.f / (1048576.f * 1024.f)) + 1e-6f); }
DEVI f32x4 mfma16(bf16x8 a, bf16x8 b, f32x4 c) { return __builtin_amdgcn_mfma_f32_16x16x32_bf16(a, b, c, 0, 0, 0); }


#define XB_TMO      128
#define XB_XCNT(j)  (256  + 64 * (j))
#define XB_XSUB(j)  (1280 + 64 * (j))
#define XB_XGEN(j)  (2304 + 64 * (j))
#define XB_TOP      3328
#define XB_TOPGEN   3392
#define XCD_BAR_WORDS 3456
#define XB_SPIN_CAP (1u << 18)
#define LAS3 __attribute__((address_space(3)))
DEVI unsigned xb_ld(unsigned* p) { return __hip_atomic_load(p, __ATOMIC_RELAXED, __HIP_MEMORY_SCOPE_AGENT); }
DEVI unsigned xb_add(unsigned* p, unsigned v) { return __hip_atomic_fetch_add(p, v, __ATOMIC_RELAXED, __HIP_MEMORY_SCOPE_AGENT); }
DEVI unsigned xb_xcc_id() { return (unsigned)__builtin_amdgcn_s_getreg((3 << 11) | 20) & 0xFu; }
#define XB_SPIN(cond, bar) do { unsigned _sp = 0; while (cond) { __builtin_amdgcn_s_sleep(1); \
    if ((++_sp & 255u) == 0u) { if (xb_ld(&(bar)[XB_TMO])) break; if (_sp > XB_SPIN_CAP) { atomicAdd(&(bar)[XB_TMO], 1u); break; } } } } while (0)
struct XcdBarrier { unsigned* bar; unsigned x; volatile LAS3 unsigned* st; };
DEVI XcdBarrier xcd_barrier_post(unsigned* bar, volatile LAS3 unsigned* st) {
  XcdBarrier b; b.bar = bar; b.x = xb_xcc_id(); b.st = st;
  if (threadIdx.x == 0) (void)xb_add(&bar[XB_XCNT(b.x)], 1u);
  return b;
}
DEVI void xcd_barrier_complete(unsigned* bar, unsigned x, unsigned& nloc, unsigned& nx) {
  const unsigned G = gridDim.x * gridDim.y * gridDim.z;
  unsigned sum, cnt, mine, sp = 0u;
  for (;;) {
    sum = 0u; cnt = 0u; mine = 0u;
#pragma unroll
    for (unsigned j = 0; j < 16; ++j) { const unsigned c = xb_ld(&bar[XB_XCNT(j)]); sum += c; cnt += (c > 0u) ? 1u : 0u; mine = (j == x) ? c : mine; }
    if (sum == G) break;
    __builtin_amdgcn_s_sleep(1);
    if ((++sp & 255u) == 0u) { if (xb_ld(&bar[XB_TMO])) break; if (sp > XB_SPIN_CAP) { atomicAdd(&bar[XB_TMO], 1u); break; } }
  }
  nloc = mine > 0u ? mine : 1u; nx = cnt > 0u ? cnt : 1u;
}
DEVI void xcd_barrier(const XcdBarrier& b) {
  asm volatile("s_waitcnt vmcnt(0)" ::: "memory");
  __syncthreads();
  if (threadIdx.x == 0) {
    unsigned* bar = b.bar;
    __builtin_amdgcn_s_waitcnt(0);
    unsigned nloc = b.st[0], nx = b.st[1];
    if (nloc == 0u) { xcd_barrier_complete(bar, b.x, nloc, nx); b.st[0] = nloc; b.st[1] = nx; }
    const unsigned old = xb_add(&bar[XB_XSUB(b.x)], 1u);
    const unsigned gen = old / nloc;
    if (old + 1u == (gen + 1u) * nloc) {
      __builtin_amdgcn_fence(__ATOMIC_RELEASE, "agent");
      asm volatile("s_waitcnt vmcnt(0)" ::: "memory");
      const unsigned og = xb_add(&bar[XB_TOP], 1u);
      const unsigned tg = og / nx;
      if (og + 1u == (tg + 1u) * nx) xb_add(&bar[XB_TOPGEN], 1u);
      else XB_SPIN(xb_ld(&bar[XB_TOPGEN]) == tg, bar);
      __builtin_amdgcn_fence(__ATOMIC_ACQUIRE, "agent");
      xb_add(&bar[XB_XGEN(b.x)], 1u);
      asm volatile("s_waitcnt vmcnt(0)" ::: "memory");
    } else {
      XB_SPIN(xb_ld(&bar[XB_XGEN(b.x)]) == gen, bar);
      __builtin_amdgcn_fence(__ATOMIC_ACQUIRE, "agent");
      asm volatile("s_waitcnt vmcnt(0)" ::: "memory");
    }
  }
  __syncthreads();
}

DEVI void transpose_tile(const float* W, int K, int Nsrc, u16* Wt, const float* gain, int perm, int tk, int tn, float* sm) {
  const int tid = threadIdx.x;
  const int n0 = tn * 256, k0 = tk * 64;
  {
    const int c4 = tid & 63, kr = tid >> 6;
    const int np = c4 * 4;
    const int src = perm ? ((np < 128) ? (tn * 128 + np) : (Nsrc / 2 + tn * 128 + (np - 128))) : (n0 + np);
    float4 v[8];
#pragma unroll
    for (int i = 0; i < 8; i++) v[i] = *(const float4*)(W + (size_t)(k0 + kr + 8 * i) * Nsrc + src);
#pragma unroll
    for (int i = 0; i < 8; i++) {
      const int kl = kr + 8 * i;
      const float g = gain ? gain[k0 + kl] : 1.f;
      float* d = sm + kl * 257 + np;
      d[0] = v[i].x * g; d[1] = v[i].y * g; d[2] = v[i].z * g; d[3] = v[i].w * g;
    }
  }
  __syncthreads();
  {
    const int kg = tid & 7, nn = tid >> 3;
#pragma unroll
    for (int i = 0; i < 4; i++) {
      const int nl = nn + 64 * i;
      const float* c = sm + (kg * 8) * 257 + nl;
      uint4 o;
      o.x = pack2(c[0], c[257]); o.y = pack2(c[2 * 257], c[3 * 257]); o.z = pack2(c[4 * 257], c[5 * 257]); o.w = pack2(c[6 * 257], c[7 * 257]);
      *(uint4*)(Wt + (size_t)(n0 + nl) * K + k0 + kg * 8) = o;
    }
  }
  __syncthreads();
}

DEVI void phase_prep(const Params& p, char* smem) {
  float* sm = (float*)smem;
  for (int t = blockIdx.x; t < 1440; t += gridDim.x) {
    const float* W; int K, N, perm; u16* Wt; const float* gain; int tt = t;
    if (tt < 192) { W = p.in[10]; K = 1024; N = 3072; perm = 0; Wt = (u16*)(p.ws + WS_WIN); gain = p.in[7]; }
    else if ((tt -= 192) < 64) { W = p.in[12]; K = 1024; N = 1024; perm = 0; Wt = (u16*)(p.ws + WS_WOUT); gain = nullptr; }
    else if ((tt -= 64) < 704) { int l = tt / 352; tt -= l * 352; W = p.in[22] + (size_t)l * 1024 * 5632; K = 1024; N = 5632; perm = 1;
                                 Wt = (u16*)(p.ws + WS_WF1 + l * SZ_WF1); gain = p.in[8] + l * 1024; }
    else if ((tt -= 704) < 352) { int l = tt / 176; tt -= l * 176; W = p.in[23] + (size_t)l * 2816 * 1024; K = 2816; N = 1024; perm = 0;
                                  Wt = (u16*)(p.ws + WS_WF2 + l * SZ_WF2); gain = nullptr; }
    else { tt -= 352; W = p.in[21]; K = 1024; N = 2048; perm = 1; Wt = (u16*)(p.ws + WS_WGLU); gain = nullptr; }
    int ntn = N / 256;
    transpose_tile(W, K, N, Wt, gain, perm, tt / ntn, tt % ntn, sm);
  }
  {
    u64* ssq = (u64*)(p.ws + WS_SSQ);
    for (int i = blockIdx.x * NTHR + threadIdx.x; i < 4 * TT; i += gridDim.x * NTHR) ssq[i] = 0ull;
  }
  int lane = threadIdx.x & 63, wid = threadIdx.x >> 6;
  u16* xb = (u16*)(p.ws + WS_B);
  const int nw = gridDim.x * 8;
  for (int row = blockIdx.x * 8 + wid; row < TT; row += nw * 4) {
    float4 v[4][4];
    float ss[4] = {0.f, 0.f, 0.f, 0.f};
#pragma unroll
    for (int r = 0; r < 4; r++) {
      const int rr = row + r * nw;
      if (rr < TT) {
        const float* src = (rr < TP) ? (p.in[0] + (size_t)rr * DM) : (p.in[1] + (size_t)(rr - TP) * DM);
#pragma unroll
        for (int i = 0; i < 4; i++) v[r][i] = *(const float4*)(src + i * 256 + lane * 4);
      }
    }
#pragma unroll
    for (int r = 0; r < 4; r++) {
      const int rr = row + r * nw;
      if (rr < TT) {
#pragma unroll
        for (int i = 0; i < 4; i++) ss[r] += v[r][i].x * v[r][i].x + v[r][i].y * v[r][i].y + v[r][i].z * v[r][i].z + v[r][i].w * v[r][i].w;
#pragma unroll
        for (int o = 32; o > 0; o >>= 1) ss[r] += __shfl_xor(ss[r], o, 64);
        const float rstd = rsqrtf(ss[r] * (1.f / 1024.f) + 1e-6f);
#pragma unroll
        for (int i = 0; i < 4; i++) {
          uint2 o;
          o.x = pack2(v[r][i].x * rstd, v[r][i].y * rstd);
          o.y = pack2(v[r][i].z * rstd, v[r][i].w * rstd);
          *(uint2*)(xb + (size_t)rr * DM + i * 256 + lane * 4) = o;
        }
      }
    }
  }
}

namespace pg8 {
#define PG8_LAS __attribute__((address_space(3)))
constexpr int BM = 256, BK = 64, HALF = 128, HTB = HALF * BK * 2, STAGE_BYTES = 8 * HTB, NXCD = 8, WGM = 8;
DEVI int lds_byte(int r, int c) { const int st = (r >> 4) * 2 + (c >> 5), rr = r & 15, cc = c & 31, ob = rr * 64 + cc * 2; return st * 1024 + (ob ^ (((ob >> 9) & 1) << 5)); }
DEVI void stage_rc(int b, int& R, int& C) { const int st = b / 1024, sb = b % 1024, swz = sb ^ (((sb >> 9) & 1) << 5); R = (st >> 1) * 16 + swz / 64; C = (st & 1) * 32 + (swz % 64) / 2; }
struct Unit { int pm, pn; };
struct Gemm { const u16* A; const u16* Bt; int M, N, K; };
struct StaticOrder {
  int nM, nN, nwg, G, c;
  DEVI void init(int M, int N, int G_, int c_) { nM = M / BM; nN = N / BM; nwg = nM * nN; G = G_; c = c_; }
  DEVI bool next(int i, Unit& u) const {
    const long L = (long)i * G + c; if (L >= nwg) return false;
    int wgid = (int)L; { const int q = nwg / NXCD, r = nwg % NXCD, xcd = wgid % NXCD, off = wgid / NXCD; wgid = (xcd < r ? xcd * (q + 1) : r * (q + 1) + (xcd - r) * q) + off; }
    const int nig = WGM * nN, gid = wgid / nig, fm = gid * WGM, gsz = (nM - fm) < WGM ? (nM - fm) : WGM;
    u.pm = fm + ((wgid % nig) % gsz); u.pn = (wgid % nig) / gsz; return true;
  }
};

template <class Epi>
DEVI void gemm_phase(PG8_LAS unsigned char* lds, const Gemm g, const StaticOrder& S, const Epi& E) {
  int tid_ = threadIdx.x; asm volatile("" : "+v"(tid_));
  const int tid = tid_, wid = __builtin_amdgcn_readfirstlane(tid >> 6), lane = tid & 63, wr = wid >> 2, wc = wid & 3, fr = lane & 15, fq = lane >> 4;
  const int K = g.K, nt = K / BK;
  unsigned voffA[2];
#pragma unroll
  for (int i = 0; i < 2; ++i) { int R, C; stage_rc(tid * 16 + i * 8192, R, C); voffA[i] = (unsigned)(R * K + C) * 2u; }
  const size_t kstep = (size_t)(BK * 2);
  const size_t hstep = (size_t)HALF * K * 2;
  const size_t tstep = 2 * hstep;
  const unsigned ldsw = (unsigned)wid * 1024u;
  const int aoff = lds_byte(wr * 64 + fr, fq * 8), boff = lds_byte(wc * 32 + fr, fq * 8);
#define PG8_SA(b, h) (((b) * 2 + (h)) * HTB)
#define PG8_SB(b, h) ((4 + (b) * 2 + (h)) * HTB)
#define PG8_STAGE(bufoff, gbase, voff) do { _Pragma("unroll") for (int _i = 0; _i < 2; ++_i) \
    __builtin_amdgcn_global_load_lds((const unsigned*)((const char*)(gbase) + (voff)[_i]), (PG8_LAS unsigned*)(lds + (bufoff) + ldsw + _i * 8192), 16, 0, 0); } while (0)
#define PG8_LDA(dst, b, h) do { _Pragma("unroll") for (int m = 0; m < 4; ++m) _Pragma("unroll") for (int k = 0; k < 2; ++k) dst[m][k] = *(const PG8_LAS bf16x8*)(lds + PG8_SA(b, h) + aoff + m * 2048 + k * 1024); } while (0)
#define PG8_LDB(dst, b, h) do { _Pragma("unroll") for (int n = 0; n < 2; ++n) _Pragma("unroll") for (int k = 0; k < 2; ++k) dst[n][k] = *(const PG8_LAS bf16x8*)(lds + PG8_SB(b, h) + boff + n * 2048 + k * 1024); } while (0)
#define PG8_MMA(ai, bj, At, Bt) do { __builtin_amdgcn_s_setprio(1); _Pragma("unroll") for (int m = 0; m < 4; ++m) _Pragma("unroll") for (int n = 0; n < 2; ++n) _Pragma("unroll") for (int k = 0; k < 2; ++k) \
    acc[ai][bj][m][n] = __builtin_amdgcn_mfma_f32_16x16x32_bf16(Bt[n][k], At[m][k], acc[ai][bj][m][n], 0, 0, 0); __builtin_amdgcn_s_setprio(0); } while (0)
#define PG8_WAIT_V(n) asm volatile("s_waitcnt vmcnt(" #n ")" ::: "memory")
#define PG8_WAIT_L(n) asm volatile("s_waitcnt lgkmcnt(" #n ")" ::: "memory")
#define PG8_BAR __builtin_amdgcn_s_barrier()
#define PG8_SCHED __builtin_amdgcn_sched_barrier(0)
  Unit cur, nxt; int ui = 0;
  if (!S.next(0, cur)) return;
  f32x4 acc[2][2][4][2];
#pragma unroll
  for (int a = 0; a < 2; ++a)
#pragma unroll
    for (int b = 0; b < 2; ++b)
#pragma unroll
      for (int m = 0; m < 4; ++m)
#pragma unroll
        for (int n = 0; n < 2; ++n) acc[a][b][m][n] = (f32x4){0.f, 0.f, 0.f, 0.f};
  bf16x8 At[4][2], B0[2][2], B1[2][2];
  const char* cA = (const char*)g.A + (size_t)cur.pm * tstep; const char* cB = (const char*)g.Bt + (size_t)cur.pn * tstep;
  PG8_STAGE(PG8_SB(0, 0), cB, voffA); PG8_STAGE(PG8_SA(0, 0), cA, voffA); PG8_STAGE(PG8_SB(0, 1), cB + hstep, voffA); PG8_STAGE(PG8_SA(0, 1), cA + hstep, voffA);
  if (wr == 1) PG8_BAR;
  PG8_WAIT_V(4); PG8_BAR;
  PG8_STAGE(PG8_SB(1, 0), cB + kstep, voffA); PG8_STAGE(PG8_SA(1, 0), cA + kstep, voffA); PG8_STAGE(PG8_SB(1, 1), cB + hstep + kstep, voffA);
  PG8_WAIT_V(6); PG8_BAR;
  for (;;) {
    const bool has_next = S.next(ui + 1, nxt);
    const char* nA = has_next ? (const char*)g.A + (size_t)nxt.pm * tstep : cA; const char* nB = has_next ? (const char*)g.Bt + (size_t)nxt.pn * tstep : cB;
    for (int t = 0; t < nt; t += 2) {
      const bool last = (t == nt - 2);
      const char* a1 = cA + (size_t)(t + 1) * kstep;
      const char* a2 = last ? nA : cA + (size_t)(t + 2) * kstep; const char* b2 = last ? nB : cB + (size_t)(t + 2) * kstep;
      const char* a3 = a2 + kstep; const char* b3 = b2 + kstep;
      PG8_LDB(B0, 0, 0); PG8_SCHED; PG8_LDA(At, 0, 0); PG8_STAGE(PG8_SA(1, 1), a1 + hstep, voffA);
      PG8_WAIT_L(8); PG8_BAR; PG8_WAIT_L(0); PG8_MMA(0, 0, At, B0); PG8_BAR; PG8_SCHED;
      PG8_LDB(B1, 0, 1); PG8_STAGE(PG8_SB(0, 0), b2, voffA);
      PG8_BAR; PG8_WAIT_L(0); PG8_MMA(0, 1, At, B1); PG8_BAR;
      PG8_LDA(At, 0, 1); PG8_STAGE(PG8_SA(0, 0), a2, voffA);
      PG8_BAR; PG8_WAIT_L(0); PG8_MMA(1, 0, At, B0); PG8_BAR; PG8_SCHED;
      PG8_STAGE(PG8_SB(0, 1), b2 + hstep, voffA);
      PG8_WAIT_V(6); PG8_BAR; PG8_MMA(1, 1, At, B1); PG8_BAR;
      PG8_LDB(B0, 1, 0); PG8_SCHED; PG8_LDA(At, 1, 0); PG8_STAGE(PG8_SA(0, 1), a2 + hstep, voffA);
      PG8_WAIT_L(8); PG8_BAR; PG8_WAIT_L(0); PG8_MMA(0, 0, At, B0); PG8_BAR; PG8_SCHED;
      PG8_LDB(B1, 1, 1); PG8_STAGE(PG8_SB(1, 0), b3, voffA);
      PG8_BAR; PG8_WAIT_L(0); PG8_MMA(0, 1, At, B1); PG8_BAR;
      PG8_LDA(At, 1, 1); PG8_STAGE(PG8_SA(1, 0), a3, voffA);
      PG8_BAR; PG8_WAIT_L(0); PG8_MMA(1, 0, At, B0); PG8_BAR; PG8_SCHED;
      PG8_STAGE(PG8_SB(1, 1), b3 + hstep, voffA);
      PG8_WAIT_V(6); PG8_BAR; PG8_MMA(1, 1, At, B1); PG8_BAR;
    }
    E(acc, cur, wr, wc, fr, fq);
    if (!has_next) break;
#pragma unroll
    for (int a = 0; a < 2; ++a)
#pragma unroll
      for (int b = 0; b < 2; ++b)
#pragma unroll
        for (int m = 0; m < 4; ++m)
#pragma unroll
          for (int n = 0; n < 2; ++n) acc[a][b][m][n] = (f32x4){0.f, 0.f, 0.f, 0.f};
    cur = nxt; cA = nA; cB = nB; ++ui;
  }
  PG8_WAIT_V(0);
  if (wr == 0) PG8_BAR;
  PG8_BAR;
#undef PG8_SA
#undef PG8_SB
#undef PG8_STAGE
#undef PG8_LDA
#undef PG8_LDB
#undef PG8_MMA
#undef PG8_WAIT_V
#undef PG8_WAIT_L
#undef PG8_BAR
#undef PG8_SCHED
}
}

typedef f32x4 AccT[2][2][4][2];
struct EpiQKV {
  u16* qkv; float* out;
  DEVI void operator()(AccT& acc, const pg8::Unit& u, int wr, int wc, int fr, int fq) const {
#pragma unroll
    for (int ai = 0; ai < 2; ai++)
#pragma unroll
      for (int m = 0; m < 4; m++) {
        const int row = 256 * u.pm + 128 * ai + 64 * wr + 16 * m + fr;
#pragma unroll
        for (int bj = 0; bj < 2; bj++)
#pragma unroll
          for (int n = 0; n < 2; n++) {
            const int col = 256 * u.pn + 128 * bj + 32 * wc + 16 * n + 4 * fq;
            f32x4 v = acc[ai][bj][m][n];
            uint2 o; o.x = pack2(v[0], v[1]); o.y = pack2(v[2], v[3]);
            *(uint2*)(qkv + (size_t)row * QW + col) = o;
            if (col >= 2048) {
              const int isv = col >= 2560;
              const int c2 = col - (isv ? 2560 : 2048);
              float* dst = nullptr;
              if (row < TP) {
                int b = row >> 13, s = row & 8191;
                if (s >= 6144) dst = out + (isv ? O_VP : O_KP) + ((size_t)b * 2048 + (s - 6144)) * 512 + c2;
              } else {
                int r2 = row - TP; int b = r2 >> 3, t = r2 & 7;
                dst = out + (isv ? O_VS : O_KS) + ((size_t)b * 2048 + 2040 + t) * 512 + c2;
              }
              if (dst) *(float4*)dst = make_float4(v[0], v[1], v[2], v[3]);
            }
          }
      }
  }
};
DEVI float4 ld_bf4(const u16* p) { const uint2 r = *(const uint2*)p; return make_float4(__uint_as_float(r.x << 16), __uint_as_float(r.x & 0xffff0000u), __uint_as_float(r.y << 16), __uint_as_float(r.y & 0xffff0000u)); }
struct EpiRes {
  u16* yb; u64* ssq; const float* x0; const float* x1;
  DEVI void operator()(AccT& acc, const pg8::Unit& u, int wr, int wc, int fr, int fq) const {
#pragma unroll
    for (int ai = 0; ai < 2; ai++)
#pragma unroll
      for (int m = 0; m < 4; m++) {
        const int row = 256 * u.pm + 128 * ai + 64 * wr + 16 * m + fr;
        float ss = 0.f;
#pragma unroll
        for (int bj = 0; bj < 2; bj++)
#pragma unroll
          for (int n = 0; n < 2; n++) {
            const int col = 256 * u.pn + 128 * bj + 32 * wc + 16 * n + 4 * fq;
            float4 r;
            if (x0) r = *(const float4*)(x0 + (size_t)row * DM + col);
            else r = ld_bf4(yb + (size_t)row * DM + col);
            f32x4 v = acc[ai][bj][m][n];
            float4 o = make_float4(r.x + v[0], r.y + v[1], r.z + v[2], r.w + v[3]);
            ss += o.x * o.x + o.y * o.y + o.z * o.z + o.w * o.w;
            uint2 ob; ob.x = pack2(o.x, o.y); ob.y = pack2(o.z, o.w);
            *(uint2*)(yb + (size_t)row * DM + col) = ob;
          }
        ss += __shfl_xor(ss, 16, 64);
        ss += __shfl_xor(ss, 32, 64);
        if (fq == 0) ssq_add(ssq + row, ss);
      }
  }
};
struct EpiSwiglu {
  u16* hid; const u64* ssq;
  DEVI void operator()(AccT& acc, const pg8::Unit& u, int wr, int wc, int fr, int fq) const {
#pragma unroll
    for (int ai = 0; ai < 2; ai++)
#pragma unroll
      for (int m = 0; m < 4; m++) {
        const int row = 256 * u.pm + 128 * ai + 64 * wr + 16 * m + fr;
        const float rs = ssq_rstd(ssq + row);
#pragma unroll
        for (int n = 0; n < 2; n++) {
          const int col = 128 * u.pn + 32 * wc + 16 * n + 4 * fq;
          f32x4 g = acc[ai][0][m][n], up = acc[ai][1][m][n];
          float h0 = siluf(g[0] * rs) * (up[0] * rs), h1 = siluf(g[1] * rs) * (up[1] * rs);
          float h2 = siluf(g[2] * rs) * (up[2] * rs), h3 = siluf(g[3] * rs) * (up[3] * rs);
          uint2 o; o.x = pack2(h0, h1); o.y = pack2(h2, h3);
          *(uint2*)(hid + (size_t)row * FF + col) = o;
        }
      }
  }
};
struct EpiGlu {
  u16* yb; u64* ssq;
  DEVI void operator()(AccT& acc, const pg8::Unit& u, int wr, int wc, int fr, int fq) const {
#pragma unroll
    for (int ai = 0; ai < 2; ai++)
#pragma unroll
      for (int m = 0; m < 4; m++) {
        const int row = 256 * u.pm + 128 * ai + 64 * wr + 16 * m + fr;
        float ss = 0.f;
#pragma unroll
        for (int n = 0; n < 2; n++) {
          const int col = 128 * u.pn + 32 * wc + 16 * n + 4 * fq;
          f32x4 va = acc[ai][0][m][n], ga = acc[ai][1][m][n];
          float4 r = ld_bf4(yb + (size_t)row * DM + col);
          float4 o = make_float4(r.x + va[0] * sigmf(ga[0]), r.y + va[1] * sigmf(ga[1]),
                                 r.z + va[2] * sigmf(ga[2]), r.w + va[3] * sigmf(ga[3]));
          ss += o.x * o.x + o.y * o.y + o.z * o.z + o.w * o.w;
          uint2 ob; ob.x = pack2(o.x, o.y); ob.y = pack2(o.z, o.w);
          *(uint2*)(yb + (size_t)row * DM + col) = ob;
        }
        ss += __shfl_xor(ss, 16, 64);
        ss += __shfl_xor(ss, 32, 64);
        if (fq == 0) ssq_add(ssq + row, ss);
      }
  }
};

template <class Epi>
DEVI void run_gemm(char* smem, const u16* A, const u16* Bt, int N, int K, const Epi& E) {
  __syncthreads();
  pg8::Gemm g{A, Bt, TP, N, K};
  pg8::StaticOrder S; S.init(TP, N, gridDim.x, blockIdx.x);
  pg8::gemm_phase((PG8_LAS unsigned char*)smem, g, S, E);
  __syncthreads();
}

DEVI float4 sum8(const float* red, int r, int c) {
  float4 a = *(const float4*)(red + r * 68 + c);
#pragma unroll
  for (int w = 1; w < 8; w++) {
    float4 b = *(const float4*)(red + w * 2176 + r * 68 + c);
    a.x += b.x; a.y += b.y; a.z += b.z; a.w += b.w;
  }
  return a;
}
struct SEpiQKV {
  u16* qkv; float* out;
  DEVI void operator()(const float* red, int row0, int cg, int tid) const {
    const int r = tid >> 4, c = (tid & 15) * 4;
    float4 v = sum8(red, r, c);
    const int row = row0 + r, col = cg * 64 + c;
    uint2 o; o.x = pack2(v.x, v.y); o.y = pack2(v.z, v.w);
    *(uint2*)(qkv + (size_t)row * QW + col) = o;
    if (col >= 2048) {
      const int isv = col >= 2560;
      const int c2 = col - (isv ? 2560 : 2048);
      const int r2 = row - TP, b = r2 >> 3, t = r2 & 7;
      *(float4*)(out + (isv ? O_VS : O_KS) + ((size_t)b * 2048 + 2040 + t) * 512 + c2) = v;
    }
  }
};
struct SEpiRes {
  u16* yb; u64* ssq; const float* x1;
  DEVI void operator()(const float* red, int row0, int cg, int tid) const {
    const int r = tid >> 4, c = (tid & 15) * 4;
    float4 v = sum8(red, r, c);
    const int row = row0 + r, col = cg * 64 + c;
    float4 rr;
    if (x1) rr = *(const float4*)(x1 + (size_t)(row - TP) * DM + col);
    else rr = ld_bf4(yb + (size_t)row * DM + col);
    float4 o = make_float4(rr.x + v.x, rr.y + v.y, rr.z + v.z, rr.w + v.w);
    uint2 ob; ob.x = pack2(o.x, o.y); ob.y = pack2(o.z, o.w); *(uint2*)(yb + (size_t)row * DM + col) = ob;
    float ss = o.x * o.x + o.y * o.y + o.z * o.z + o.w * o.w;
#pragma unroll
    for (int of = 1; of < 16; of <<= 1) ss += __shfl_xor(ss, of, 64);
    if ((tid & 15) == 0) ssq_add(ssq + row, ss);
  }
};
struct SEpiSwiglu {
  u16* hid; const u64* ssq;
  DEVI void operator()(const float* red, int row0, int cg, int tid) const {
    if (tid < 256) {
      const int r = tid >> 3, c = (tid & 7) * 4;
      float4 g = sum8(red, r, c), u = sum8(red, r, 32 + c);
      const int row = row0 + r, col = cg * 32 + c;
      const float rs = ssq_rstd(ssq + row);
      uint2 o;
      o.x = pack2(siluf(g.x * rs) * (u.x * rs), siluf(g.y * rs) * (u.y * rs));
      o.y = pack2(siluf(g.z * rs) * (u.z * rs), siluf(g.w * rs) * (u.w * rs));
      *(uint2*)(hid + (size_t)row * FF + col) = o;
    }
  }
};
struct SEpiGlu {
  u16* yb; u64* ssq;
  DEVI void operator()(const float* red, int row0, int cg, int tid) const {
    if (tid < 256) {
      const int r = tid >> 3, c = (tid & 7) * 4;
      float4 va = sum8(red, r, c), ga = sum8(red, r, 32 + c);
      const int row = row0 + r, col = cg * 32 + c;
      float4 rr = ld_bf4(yb + (size_t)row * DM + col);
      float4 o = make_float4(rr.x + va.x * sigmf(ga.x), rr.y + va.y * sigmf(ga.y), rr.z + va.z * sigmf(ga.z), rr.w + va.w * sigmf(ga.w));
      uint2 ob; ob.x = pack2(o.x, o.y); ob.y = pack2(o.z, o.w);
      *(uint2*)(yb + (size_t)row * DM + col) = ob;
      float ss = o.x * o.x + o.y * o.y + o.z * o.z + o.w * o.w;
#pragma unroll
      for (int of = 1; of < 8; of <<= 1) ss += __shfl_xor(ss, of, 64);
      if ((tid & 7) == 0) ssq_add(ssq + row, ss);
    }
  }
};

template <class EpiS>
DEVI void sample_gemm(char* smem, const u16* A, const u16* Bt, int K, int ncg, bool paired, const EpiS& E, int fb = 0) {
  int tid_ = threadIdx.x; asm volatile("" : "+v"(tid_));
  const int tid = tid_, lane = tid & 63, w = tid >> 6, fr = lane & 15, fq = lane >> 4;
  const int ksl = K >> 3, nks = ksl >> 5;
  float* red = (float*)smem;
  for (int it = (int)blockIdx.x - fb; it >= 0 && it < ncg * 8; it += (int)gridDim.x - fb) {
    const int rg = it & 7, cg = it >> 3;
    const int row0 = TP + rg * 32;
    int wrow[4];
    if (paired) { const int base = (cg >> 2) * 256 + (cg & 3) * 32; wrow[0] = base; wrow[1] = base + 16; wrow[2] = base + 128; wrow[3] = base + 144; }
    else { const int base = cg * 64; wrow[0] = base; wrow[1] = base + 16; wrow[2] = base + 32; wrow[3] = base + 48; }
    f32x4 acc[2][4];
#pragma unroll
    for (int m = 0; m < 2; m++)
#pragma unroll
      for (int n = 0; n < 4; n++) acc[m][n] = (f32x4){0.f, 0.f, 0.f, 0.f};
    const u16* ap = A + (size_t)(row0 + fr) * K + w * ksl + fq * 8;
    const u16* bp = Bt + (size_t)fr * K + w * ksl + fq * 8;
#pragma unroll 4
    for (int ks = 0; ks < nks; ks++) {
      bf16x8 a0 = *(const bf16x8*)(ap + ks * 32), a1 = *(const bf16x8*)(ap + (size_t)16 * K + ks * 32);
      bf16x8 bb[4];
#pragma unroll
      for (int n = 0; n < 4; n++) bb[n] = *(const bf16x8*)(bp + (size_t)wrow[n] * K + ks * 32);
#pragma unroll
      for (int n = 0; n < 4; n++) { acc[0][n] = mfma16(bb[n], a0, acc[0][n]); acc[1][n] = mfma16(bb[n], a1, acc[1][n]); }
    }
#pragma unroll
    for (int m = 0; m < 2; m++)
#pragma unroll
      for (int n = 0; n < 4; n++)
        *(float4*)(red + w * 2176 + (m * 16 + fr) * 68 + n * 16 + 4 * fq) = make_float4(acc[m][n][0], acc[m][n][1], acc[m][n][2], acc[m][n][3]);
    __syncthreads();
    E(red, row0, cg, tid);
    __syncthreads();
  }
}

DEVI float ret_log2g(int h) { return log2f(1.f - exp2f(-5.f - (float)h)); }

struct RuRegs { u32x4 k0, k1, v0, v1, v2, v3; };
DEVI void ru_load(const Params& p, int item, RuRegs& R) {
  int tid_ = threadIdx.x; asm volatile("" : "+v"(tid_));
  const int tid = tid_;
  const int bh = item >> 6, c = item & 63, b = bh >> 2, h = bh & 3;
  const u16* qkv = (const u16*)(p.ws + WS_A);
  const size_t r0 = (size_t)b * 8192 + c * 128;
#define RU_K(i, KK) { const int ch = tid + i * 512, m = ch >> 3, part = ch & 7; KK = *(const u32x4*)(qkv + (r0 + m) * QW + 256 + h * 64 + part * 8); }
#define RU_V(i, VV) { const int ch = tid + i * 512, m = ch >> 4, part = ch & 15; VV = *(const u32x4*)(qkv + (r0 + m) * QW + 512 + h * 128 + part * 8); }
  RU_K(0, R.k0) RU_K(1, R.k1) RU_V(0, R.v0) RU_V(1, R.v1) RU_V(2, R.v2) RU_V(3, R.v3)
#undef RU_K
#undef RU_V
}
DEVI void ret_u_item(const Params& p, int item, char* smem, RuRegs& R, int next_item) {
  int tid_ = threadIdx.x; asm volatile("" : "+v"(tid_));
  const int tid = tid_, lane = tid & 63, w = tid >> 6, l15 = lane & 15, lq = lane >> 4;
  const int h = (item >> 6) & 3;
  const float l2g = ret_log2g(h);
  char* Kdt = smem;
  char* Vt = smem + 17408;
#define RU_SK(i, KK) { const int ch = tid + i * 512, m = ch >> 3, part = ch & 7; \
    const float sc = 0.125f * exp2f((float)(127 - m) * l2g); char* kb = Kdt + (part * 8) * 272 + m * 2; \
    *(u16*)(kb) = f2bf(__uint_as_float(KK.x << 16) * sc); *(u16*)(kb + 272) = f2bf(__uint_as_float(KK.x & 0xffff0000u) * sc); \
    *(u16*)(kb + 2 * 272) = f2bf(__uint_as_float(KK.y << 16) * sc); *(u16*)(kb + 3 * 272) = f2bf(__uint_as_float(KK.y & 0xffff0000u) * sc); \
    *(u16*)(kb + 4 * 272) = f2bf(__uint_as_float(KK.z << 16) * sc); *(u16*)(kb + 5 * 272) = f2bf(__uint_as_float(KK.z & 0xffff0000u) * sc); \
    *(u16*)(kb + 6 * 272) = f2bf(__uint_as_float(KK.w << 16) * sc); *(u16*)(kb + 7 * 272) = f2bf(__uint_as_float(KK.w & 0xffff0000u) * sc); }
#define RU_SV(i, VV) { const int ch = tid + i * 512, m = ch >> 4, part = ch & 15; char* vb = Vt + (part * 8) * 272 + m * 2; \
    *(u16*)(vb) = (u16)(VV.x & 0xffffu); *(u16*)(vb + 272) = (u16)(VV.x >> 16); \
    *(u16*)(vb + 2 * 272) = (u16)(VV.y & 0xffffu); *(u16*)(vb + 3 * 272) = (u16)(VV.y >> 16); \
    *(u16*)(vb + 4 * 272) = (u16)(VV.z & 0xffffu); *(u16*)(vb + 5 * 272) = (u16)(VV.z >> 16); \
    *(u16*)(vb + 6 * 272) = (u16)(VV.w & 0xffffu); *(u16*)(vb + 7 * 272) = (u16)(VV.w >> 16); }
  RU_SK(0, R.k0) RU_SK(1, R.k1) RU_SV(0, R.v0) RU_SV(1, R.v1) RU_SV(2, R.v2) RU_SV(3, R.v3)
#undef RU_SK
#undef RU_SV
  __syncthreads();
  if (next_item >= 0) ru_load(p, next_item, R);
  f32x4 acc[4];
#pragma unroll
  for (int d = 0; d < 4; d++) acc[d] = (f32x4){0.f, 0.f, 0.f, 0.f};
#pragma unroll
  for (int ks = 0; ks < 4; ks++) {
    bf16x8 a = *(const bf16x8*)(Vt + (16 * w + l15) * 272 + ks * 64 + lq * 16);
#pragma unroll
    for (int d = 0; d < 4; d++) {
      bf16x8 bb = *(const bf16x8*)(Kdt + (d * 16 + l15) * 272 + ks * 64 + lq * 16);
      acc[d] = mfma16(a, bb, acc[d]);
    }
  }
  float* UT = (float*)(p.ws + WS_UT) + (size_t)item * 8192;
#pragma unroll
  for (int d = 0; d < 4; d++)
#pragma unroll
    for (int j = 0; j < 4; j++) UT[(16 * w + lq * 4 + j) * 64 + d * 16 + l15] = acc[d][j];
  __syncthreads();
}

struct AttnRegs { u32x4 k0, k1, k2, k3, v0, v1, v2, v3; bf16x8 q0, q1; };
DEVI void attn_decode(int item, int& h, int& b, int& branch, int& dil, int& r, int& blk) {
  h = item & 7; const int cb = (item >> 3) & 63, rest = item >> 9; branch = rest % 3; b = rest / 3;
  dil = 1 << (2 * branch); const int nbc = 64 >> (2 * branch);
  r = cb / nbc; blk = cb % nbc;
}
DEVI void attn_load(const Params& p, int item, AttnRegs& R) {
  int tid_ = threadIdx.x; asm volatile("" : "+v"(tid_));
  const int tid = tid_, lane = tid & 63, w = tid >> 6, l15 = lane & 15, lq = lane >> 4;
  int h, b, branch, dil, r, blk; attn_decode(item, h, b, branch, dil, r, blk);
  const u16* qkv = (const u16*)(p.ws + WS_A);
#define ATT_LD(i, KK, VV) { const int ch = tid + i * 512, j = ch >> 3, part = ch & 7; \
    int kc = (blk - 1) * 128 + j; if (kc < 0) kc = 0; \
    const size_t row = (size_t)b * 8192 + (size_t)kc * dil + r; \
    KK = *(const u32x4*)(qkv + row * QW + 2048 + h * 64 + part * 8); \
    VV = *(const u32x4*)(qkv + row * QW + 2560 + h * 64 + part * 8); }
  ATT_LD(0, R.k0, R.v0) ATT_LD(1, R.k1, R.v1) ATT_LD(2, R.k2, R.v2) ATT_LD(3, R.k3, R.v3)
#undef ATT_LD
  const size_t rowq = (size_t)b * 8192 + (size_t)(blk * 128 + 16 * w + l15) * dil + r;
  R.q0 = *(const bf16x8*)(qkv + rowq * QW + 1536 + h * 64 + lq * 8);
  R.q1 = *(const bf16x8*)(qkv + rowq * QW + 1536 + h * 64 + 32 + lq * 8);
}
constexpr int AT_VT = 272 * 144;
DEVI void attn_stage(const AttnRegs& R, char* smem) {
  int tid_ = threadIdx.x; asm volatile("" : "+v"(tid_));
  const int tid = tid_;
  char* Ks = smem; char* Vt = smem + AT_VT;
#define ATT_ST(i, KK, VV) { const int ch = tid + i * 512, j = ch >> 3, part = ch & 7; \
    *(u32x4*)(Ks + j * 144 + part * 16) = KK; \
    const int jx = j ^ (part * 8); char* vb = Vt + (part * 8) * 656 + jx * 2; \
    *(u16*)(vb) = (u16)(VV.x & 0xffffu); *(u16*)(vb + 656) = (u16)(VV.x >> 16); \
    *(u16*)(vb + 2 * 656) = (u16)(VV.y & 0xffffu); *(u16*)(vb + 3 * 656) = (u16)(VV.y >> 16); \
    *(u16*)(vb + 4 * 656) = (u16)(VV.z & 0xffffu); *(u16*)(vb + 5 * 656) = (u16)(VV.z >> 16); \
    *(u16*)(vb + 6 * 656) = (u16)(VV.w & 0xffffu); *(u16*)(vb + 7 * 656) = (u16)(VV.w >> 16); }
  ATT_ST(0, R.k0, R.v0) ATT_ST(1, R.k1, R.v1) ATT_ST(2, R.k2, R.v2) ATT_ST(3, R.k3, R.v3)
#undef ATT_ST
}
DEVI void attn_compute(const Params& p, int item, const bf16x8 qf0, const bf16x8 qf1, char* smem) {
  int tid_ = threadIdx.x; asm volatile("" : "+v"(tid_));
  const int tid = tid_, lane = tid & 63, w = tid >> 6, l15 = lane & 15, lq = lane >> 4;
  int h, b, branch, dil, r, blk; attn_decode(item, h, b, branch, dil, r, blk);
  const char* Ks = smem; const char* Vt = smem + AT_VT;
  const float sd = exp2f(-(float)(h + 1)) * (float)dil;
  f32x4 sT[9];
#pragma unroll
  for (int t = 0; t < 9; t++) {
    sT[t] = (f32x4){0.f, 0.f, 0.f, 0.f};
#pragma unroll
    for (int ks = 0; ks < 2; ks++) {
      bf16x8 kf = *(const bf16x8*)(Ks + ((w + t) * 16 + l15) * 144 + ks * 64 + lq * 16);
      sT[t] = mfma16(kf, ks ? qf1 : qf0, sT[t]);
    }
  }
  float mx = -3e38f;
  const float dbase = (float)(128 + l15 - lq * 4);
#pragma unroll
  for (int t = 0; t < 9; t++) {
    const bool tile_ok = (blk > 0) || (w + t >= 8);
#pragma unroll
    for (int jj = 0; jj < 4; jj++) {
      const float dist = dbase - (float)(t * 16 + jj);
      float v = sT[t][jj] * 0.125f - sd * dist;
      bool valid = tile_ok;
      if (t == 0) valid = valid && (dist <= 128.f);
      if (t == 8) valid = valid && (dist >= 0.f);
      v = valid ? v : -1e30f;
      sT[t][jj] = v;
      mx = fmaxf(mx, v);
    }
  }
  mx = fmaxf(mx, __shfl_xor(mx, 16, 64));
  mx = fmaxf(mx, __shfl_xor(mx, 32, 64));
  float den = 0.f;
  bf16x8 pf[5];
#pragma unroll
  for (int s2 = 0; s2 < 5; s2++) {
    float e[8];
#pragma unroll
    for (int jj = 0; jj < 4; jj++) { e[jj] = fexp(sT[2 * s2][jj] - mx); e[4 + jj] = (s2 < 4) ? fexp(sT[(s2 < 4) ? 2 * s2 + 1 : 0][jj] - mx) : 0.f; }
#pragma unroll
    for (int q = 0; q < 8; q++) den += e[q];
    const u32x4 o = {pack2(e[0], e[1]), pack2(e[2], e[3]), pack2(e[4], e[5]), pack2(e[6], e[7])};
    pf[s2] = __builtin_bit_cast(bf16x8, o);
  }
  den += __shfl_xor(den, 16, 64);
  den += __shfl_xor(den, 32, 64);
  f32x4 oT[4];
#pragma unroll
  for (int d = 0; d < 4; d++) oT[d] = (f32x4){0.f, 0.f, 0.f, 0.f};
#pragma unroll
  for (int s2 = 0; s2 < 5; s2++) {
    const int key0 = (w + 2 * s2) * 16 + lq * 4;
#pragma unroll
    for (int dt = 0; dt < 4; dt++) {
      const int d = dt * 16 + l15, sw = (d >> 3) * 8;
      const uint2 lo = *(const uint2*)(Vt + d * 656 + (key0 ^ sw) * 2);
      const uint2 hi = *(const uint2*)(Vt + d * 656 + ((key0 + 16) ^ sw) * 2);
      const u32x4 vv = {lo.x, lo.y, hi.x, hi.y};
      oT[dt] = mfma16(__builtin_bit_cast(bf16x8, vv), pf[s2], oT[dt]);
    }
  }
  u16* ao = (u16*)(p.ws + WS_ATTO) + (size_t)branch * TP * 512;
  float* lse = (float*)(p.ws + WS_LSE) + (size_t)branch * TP * 8;
  const size_t prow = (size_t)b * 8192 + (size_t)(blk * 128 + 16 * w + l15) * dil + r;
  const float inv = __builtin_amdgcn_rcpf(den);
#pragma unroll
  for (int dt = 0; dt < 4; dt++) {
    uint2 o; o.x = pack2(oT[dt][0] * inv, oT[dt][1] * inv); o.y = pack2(oT[dt][2] * inv, oT[dt][3] * inv);
    *(uint2*)(ao + prow * 512 + h * 64 + dt * 16 + lq * 4) = o;
  }
  if (lq == 0) lse[prow * 8 + h] = mx + logf(den);
}

DEVI void ret_sample_item(const Params& p, int item, char* smem) {
  const int tid = threadIdx.x, b = item >> 2, h = item & 3;
  const u16* qkv = (const u16*)(p.ws + WS_A);
  float* qs = (float*)smem;
  float* ks = qs + 512;
  float* sc = ks + 512;
  float* red = sc + 64;
  const float l2g = ret_log2g(h);
  const size_t r0 = (size_t)TP + b * 8;
  {
    int t = tid >> 6, d = tid & 63;
    qs[tid] = bf2f(qkv[(r0 + t) * QW + h * 64 + d]);
    ks[tid] = 0.125f * bf2f(qkv[(r0 + t) * QW + 256 + h * 64 + d]);
  }
  __syncthreads();
  if (tid < 64) {
    int n = tid >> 3, m = tid & 7;
    float a = 0.f;
    for (int d = 0; d < 64; d++) a += qs[n * 64 + d] * ks[m * 64 + d];
    sc[tid] = (n >= m) ? a * exp2f((float)(n - m) * l2g) : 0.f;
  }
  __syncthreads();
  float o[8];
  const int e = tid & 127;
  if (tid < 128) {
    float v[8];
#pragma unroll
    for (int t = 0; t < 8; t++) v[t] = bf2f(qkv[(r0 + t) * QW + 512 + h * 128 + e]);
    const float* st = p.in[2] + ((size_t)(b * 4 + h) * 64) * 128 + e;
    float* so = p.out + O_RETS + ((size_t)(b * 4 + h) * 64) * 128 + e;
    float cr[8];
#pragma unroll
    for (int t = 0; t < 8; t++) cr[t] = 0.f;
    const float g8 = exp2f(8.f * l2g);
    float vd[8];
#pragma unroll
    for (int t = 0; t < 8; t++) vd[t] = exp2f((float)(7 - t) * l2g) * v[t];
#pragma unroll 1
    for (int d0 = 0; d0 < 64; d0 += 16) {
      float sv[16];
#pragma unroll
      for (int i = 0; i < 16; i++) sv[i] = st[(size_t)(d0 + i) * 128];
#pragma unroll
      for (int i = 0; i < 16; i++) {
        const int d = d0 + i;
        float ns = g8 * sv[i];
#pragma unroll
        for (int t = 0; t < 8; t++) {
          cr[t] += qs[t * 64 + d] * sv[i];
          ns += ks[t * 64 + d] * vd[t];
        }
        so[(size_t)d * 128] = ns;
      }
    }
#pragma unroll
    for (int n = 0; n < 8; n++) {
      float a = cr[n] * exp2f((float)(n + 1) * l2g);
#pragma unroll
      for (int m = 0; m < 8; m++) a += sc[n * 8 + m] * v[m];
      o[n] = a;
    }
#pragma unroll
    for (int n = 0; n < 8; n++) {
      float s = o[n];
#pragma unroll
      for (int of = 32; of > 0; of >>= 1) s += __shfl_xor(s, of, 64);
      if ((tid & 63) == 0) red[(tid >> 6) * 8 + n] = s;
    }
  }
  __syncthreads();
  float mu[8];
  if (tid < 128) {
#pragma unroll
    for (int n = 0; n < 8; n++) { mu[n] = (red[n] + red[8 + n]) * (1.f / 128.f); o[n] -= mu[n]; }
  }
  __syncthreads();
  if (tid < 128) {
#pragma unroll
    for (int n = 0; n < 8; n++) {
      float s = o[n] * o[n];
#pragma unroll
      for (int of = 32; of > 0; of >>= 1) s += __shfl_xor(s, of, 64);
      if ((tid & 63) == 0) red[(tid >> 6) * 8 + n] = s;
    }
  }
  __syncthreads();
  if (tid < 128) {
    u16* mixed = (u16*)(p.ws + WS_B);
    const float gain = p.in[11][h * 128 + e];
#pragma unroll
    for (int n = 0; n < 8; n++) {
      float var = (red[n] + red[8 + n]) * (1.f / 128.f);
      float y = o[n] * rsqrtf(var + 1e-6f) * gain;
      float ga = bf2f(qkv[(r0 + n) * QW + 1024 + h * 128 + e]);
      mixed[(r0 + n) * DM + h * 128 + e] = f2bf(siluf(ga) * y);
    }
  }
  __syncthreads();
}

DEVI void attn_sample_item(const Params& p, int item, char* smem) {
  const int tid = threadIdx.x, lane = tid & 63, t = tid >> 6;
  const int b = item >> 3, h = item & 7;
  const u16* qkv = (const u16*)(p.ws + WS_A);
  float* qsm = (float*)smem + t * 64;
  float* psm = (float*)smem + 512 + t * 400;
  const size_t rq = (size_t)TP + b * 8 + t;
  const float slope = exp2f(-(float)(h + 1));
  qsm[lane] = 0.125f * bf2f(qkv[rq * QW + 1536 + h * 64 + lane]);
  __builtin_amdgcn_wave_barrier();
  __builtin_amdgcn_fence(__ATOMIC_ACQ_REL, "wavefront");
  const float* kpast = p.in[3] + (size_t)b * 2048 * 512 + h * 64;
  const float* vpast = p.in[4] + (size_t)b * 2048 * 512 + h * 64;
  const float* knew = p.out + O_KS + (size_t)b * 2048 * 512 + h * 64 - (size_t)8 * 512;
  const float* vnew = p.out + O_VS + (size_t)b * 2048 * 512 + h * 64 - (size_t)8 * 512;
  float sc[7];
  float mx = -3e38f;
#pragma unroll
  for (int k = 0; k < 7; k++) {
    int q = lane + 64 * k; if (q > 386) q = 386;
    const int g = (q >= 258) ? 2 : ((q >= 129) ? 1 : 0);
    const int j = q - 129 * g, dj = j << (2 * g);
    const int idx = 2048 + t - dj;
    const float4* kr = (const float4*)(((idx < 2048) ? kpast : knew) + (size_t)idx * 512);
    float a = 0.f;
#pragma unroll
    for (int d = 0; d < 16; d++) {
      float4 kk = kr[d];
      a += qsm[d * 4] * kk.x + qsm[d * 4 + 1] * kk.y + qsm[d * 4 + 2] * kk.z + qsm[d * 4 + 3] * kk.w;
    }
    a -= slope * (float)dj;
    if (lane + 64 * k > 386) a = -3e38f;
    sc[k] = a;
    mx = fmaxf(mx, a);
  }
#pragma unroll
  for (int o = 32; o > 0; o >>= 1) mx = fmaxf(mx, __shfl_xor(mx, o, 64));
  float den = 0.f;
#pragma unroll
  for (int k = 0; k < 7; k++) {
    const int q = lane + 64 * k;
    float pv = (q <= 386) ? fexp(sc[k] - mx) : 0.f;
    if (q < 400) psm[q] = pv;
    den += pv;
  }
#pragma unroll
  for (int o = 32; o > 0; o >>= 1) den += __shfl_xor(den, o, 64);
  __builtin_amdgcn_wave_barrier();
  __builtin_amdgcn_fence(__ATOMIC_ACQ_REL, "wavefront");
  const int d4 = lane & 15, kg = lane >> 4;
  float4 acc = make_float4(0.f, 0.f, 0.f, 0.f);
#pragma unroll 16
  for (int i = 0; i < 97; i++) {
    int q = 4 * i + kg;
    const float pv = psm[q];
    if (q > 386) q = 386;
    const int g = (q >= 258) ? 2 : ((q >= 129) ? 1 : 0);
    const int j = q - 129 * g, dj = j << (2 * g);
    const int idx = 2048 + t - dj;
    const float4 v = *(const float4*)(((idx < 2048) ? vpast : vnew) + (size_t)idx * 512 + d4 * 4);
    acc.x += pv * v.x; acc.y += pv * v.y; acc.z += pv * v.z; acc.w += pv * v.w;
  }
  acc.x += __shfl_xor(acc.x, 16, 64); acc.y += __shfl_xor(acc.y, 16, 64); acc.z += __shfl_xor(acc.z, 16, 64); acc.w += __shfl_xor(acc.w, 16, 64);
  acc.x += __shfl_xor(acc.x, 32, 64); acc.y += __shfl_xor(acc.y, 32, 64); acc.z += __shfl_xor(acc.z, 32, 64); acc.w += __shfl_xor(acc.w, 32, 64);
  if (lane < 16) {
    u16* mixed = (u16*)(p.ws + WS_B);
    const float inv = 1.f / den;
    uint2 o; o.x = pack2(acc.x * inv, acc.y * inv); o.y = pack2(acc.z * inv, acc.w * inv);
    *(uint2*)(mixed + rq * DM + 512 + h * 64 + d4 * 4) = o;
  }
  __syncthreads();
}

constexpr int CP_ROWS = 64 * 510;
constexpr int CP_TAIL = 8000;
constexpr int NCP_AT = 5, CP0_AT = 2 * CP_TAIL;
constexpr int NCP_RU = 3, CP0_RU = CP0_AT + 3072 * 5;
DEVI size_t cp_off(int R, int& kv) {
  const int bt = R / 510, rr = R - bt * 510;
  kv = bt >> 5;
  return (size_t)(bt & 31) * (2048 * 512 / 4) + (size_t)rr * 512 + threadIdx.x;
}
template <int N> struct CopyRegs { f32x4 v[N]; };
template <int N> DEVI void cp_load(const Params& p, int row0, CopyRegs<N>& c) {
#pragma unroll
  for (int k = 0; k < N; k++) {
    const int Rw = row0 + k;
    if (Rw < CP_ROWS) { int kv; const size_t o = cp_off(Rw, kv); c.v[k] = __builtin_nontemporal_load((const f32x4*)p.in[3 + kv] + 8 * 512 / 4 + o); }
  }
}
template <int N> DEVI void cp_store(const Params& p, int row0, const CopyRegs<N>& c) {
  asm volatile("" : "+s"(row0));
#pragma unroll
  for (int k = 0; k < N; k++) {
    const int Rw = row0 + k;
    if (Rw < CP_ROWS) { int kv; const size_t o = cp_off(Rw, kv); __builtin_nontemporal_store(c.v[k], (f32x4*)(p.out + (kv ? O_VS : O_KS)) + o); }
  }
}

DEVI void phase_mix_a(const Params& p, char* smem) {
  const int nb = gridDim.x;
  const bool late = (blockIdx.x & 1) != 0;
  if (!late) {
    for (int it = blockIdx.x; it < 256; it += nb) attn_sample_item(p, it, smem);
    {
      RuRegs RU;
      if ((int)blockIdx.x < 512) ru_load(p, blockIdx.x, RU);
      for (int it = blockIdx.x; it < 512; it += nb) {
        CopyRegs<NCP_RU> cp; cp_load(p, CP0_RU + it * NCP_RU, cp);
        ret_u_item(p, it, smem, RU, (it + nb < 512) ? it + nb : -1);
        cp_store(p, CP0_RU + it * NCP_RU, cp);
      }
    }
  }
  __syncthreads();
  if (threadIdx.x < 144) *(uint4*)(smem + 256 * 144 + threadIdx.x * 16) = make_uint4(0u, 0u, 0u, 0u);
  *(uint4*)(smem + AT_VT + (threadIdx.x >> 3) * 656 + (256 + (threadIdx.x & 7) * 8) * 2) = make_uint4(0u, 0u, 0u, 0u);
  AttnRegs R;
  if ((int)blockIdx.x < 3072) attn_load(p, blockIdx.x, R);
  for (int it = blockIdx.x; it < 3072; it += nb) {
    CopyRegs<NCP_AT> cp; cp_load(p, CP0_AT + it * NCP_AT, cp);
    attn_stage(R, smem);
    const bf16x8 qf0 = R.q0, qf1 = R.q1;
    __syncthreads();
    if (it + nb < 3072) attn_load(p, it + nb, R);
    attn_compute(p, it, qf0, qf1, smem);
    cp_store(p, CP0_AT + it * NCP_AT, cp);
    __syncthreads();
  }
  if (late) {
    for (int it = blockIdx.x; it < 256; it += nb) attn_sample_item(p, it, smem);
    {
      RuRegs RU;
      if ((int)blockIdx.x < 512) ru_load(p, blockIdx.x, RU);
      for (int it = blockIdx.x; it < 512; it += nb) {
        CopyRegs<NCP_RU> cp; cp_load(p, CP0_RU + it * NCP_RU, cp);
        ret_u_item(p, it, smem, RU, (it + nb < 512) ? it + nb : -1);
        cp_store(p, CP0_RU + it * NCP_RU, cp);
      }
    }
  }
}

DEVI void phase_mix_b(const Params& p) {
  const int gt = blockIdx.x * NTHR + threadIdx.x, gn = gridDim.x * NTHR;
  if (gt < 65536) {
    const int bh = gt >> 13, rem = gt & 8191, h = bh & 3;
    const float dec = exp2f(128.f * ret_log2g(h));
    const float* UT = (const float*)(p.ws + WS_UT) + (size_t)bh * 64 * 8192 + rem;
    u16* SPT = (u16*)(p.ws + WS_SPT) + (size_t)bh * 64 * 8192 + rem;
    float S = 0.f;
#pragma unroll 8
    for (int c = 0; c < 64; c++) {
      SPT[(size_t)c * 8192] = f2bf(S);
      S = dec * S + UT[(size_t)c * 8192];
    }
    const int e = rem >> 6, d = rem & 63;
    p.out[O_RETP + (size_t)bh * 8192 + d * 128 + e] = S;
  }
  const u16* ao = (const u16*)(p.ws + WS_ATTO);
  const float* lse = (const float*)(p.ws + WS_LSE);
  u16* mixed = (u16*)(p.ws + WS_B);
#pragma unroll 8
  for (int i = gt; i < TP * 64; i += gn) {
    const int row = i >> 6, h = (i >> 3) & 7, part = i & 7;
    float l0 = lse[(size_t)row * 8 + h], l1 = lse[(size_t)(TP + row) * 8 + h], l2 = lse[(size_t)(2 * TP + row) * 8 + h];
    float M = fmaxf(l0, fmaxf(l1, l2));
    float w0 = fexp(l0 - M), w1 = fexp(l1 - M), w2 = fexp(l2 - M);
    float inv = 1.f / (w0 + w1 + w2);
    w0 *= inv; w1 *= inv; w2 *= inv;
    const size_t off = (size_t)row * 512 + h * 64 + part * 8;
    uint4 a0 = *(const uint4*)(ao + off), a1 = *(const uint4*)(ao + (size_t)TP * 512 + off), a2 = *(const uint4*)(ao + (size_t)2 * TP * 512 + off);
    const u16* e0 = (const u16*)&a0; const u16* e1 = (const u16*)&a1; const u16* e2 = (const u16*)&a2;
    uint4 o; unsigned* oo = (unsigned*)&o;
#pragma unroll
    for (int q = 0; q < 4; q++) {
      float x0 = w0 * bf2f(e0[2 * q]) + w1 * bf2f(e1[2 * q]) + w2 * bf2f(e2[2 * q]);
      float x1 = w0 * bf2f(e0[2 * q + 1]) + w1 * bf2f(e1[2 * q + 1]) + w2 * bf2f(e2[2 * q + 1]);
      oo[q] = pack2(x0, x1);
    }
    *(uint4*)(mixed + (size_t)row * DM + 512 + h * 64 + part * 8) = o;
  }
}

struct RoRegs { u32x4 q0, q1, k0, k1, v0, v1, v2, v3; };
DEVI void ro_load(const Params& p, int item, RoRegs& R) {
  int tid_ = threadIdx.x; asm volatile("" : "+v"(tid_));
  const int tid = tid_;
  const int bh = item >> 6, c = item & 63, b = bh >> 2, h = bh & 3;
  const u16* qkv = (const u16*)(p.ws + WS_A);
  const size_t r0 = (size_t)b * 8192 + c * 128;
#define RO_QK(i, QQ, KK) { const int ch = tid + i * 512, m = ch >> 3, part = ch & 7; \
    QQ = *(const u32x4*)(qkv + (r0 + m) * QW + h * 64 + part * 8); KK = *(const u32x4*)(qkv + (r0 + m) * QW + 256 + h * 64 + part * 8); }
#define RO_V(i, VV) { const int ch = tid + i * 512, m = ch >> 4, part = ch & 15; VV = *(const u32x4*)(qkv + (r0 + m) * QW + 512 + h * 128 + part * 8); }
  RO_QK(0, R.q0, R.k0) RO_QK(1, R.q1, R.k1) RO_V(0, R.v0) RO_V(1, R.v1) RO_V(2, R.v2) RO_V(3, R.v3)
#undef RO_QK
#undef RO_V
}
DEVI void ret_out_item(const Params& p, int item, char* smem, RoRegs& R, int next_item) {
  int tid_ = threadIdx.x; asm volatile("" : "+v"(tid_));
  const int tid = tid_, lane = tid & 63, w = tid >> 6, l15 = lane & 15, lq = lane >> 4;
  const int bh = item >> 6, c = item & 63, b = bh >> 2, h = bh & 3;
  const u16* qkv = (const u16*)(p.ws + WS_A);
  const size_t r0 = (size_t)b * 8192 + c * 128;
  const float l2g = ret_log2g(h);
  char* Qs = smem;
  char* Ks = smem + 18432;
  char* Vt = smem + 36864;
  char* Sw = smem + 36864 + 34816 + w * 4352;
#define RO_SQK(i, QQ, KK) { const int ch = tid + i * 512, m = ch >> 3, part = ch & 7; \
    *(u32x4*)(Qs + m * 144 + part * 16) = QQ; *(u32x4*)(Ks + m * 144 + part * 16) = KK; }
#define RO_SV(i, VV) { const int ch = tid + i * 512, m = ch >> 4, part = ch & 15; char* vb = Vt + (part * 8) * 272 + m * 2; \
    *(u16*)(vb) = (u16)(VV.x & 0xffffu); *(u16*)(vb + 272) = (u16)(VV.x >> 16); \
    *(u16*)(vb + 2 * 272) = (u16)(VV.y & 0xffffu); *(u16*)(vb + 3 * 272) = (u16)(VV.y >> 16); \
    *(u16*)(vb + 4 * 272) = (u16)(VV.z & 0xffffu); *(u16*)(vb + 5 * 272) = (u16)(VV.z >> 16); \
    *(u16*)(vb + 6 * 272) = (u16)(VV.w & 0xffffu); *(u16*)(vb + 7 * 272) = (u16)(VV.w >> 16); }
  RO_SQK(0, R.q0, R.k0) RO_SQK(1, R.q1, R.k1) RO_SV(0, R.v0) RO_SV(1, R.v1) RO_SV(2, R.v2) RO_SV(3, R.v3)
#undef RO_SQK
#undef RO_SV
  __syncthreads();
  if (next_item >= 0) ro_load(p, next_item, R);
  bf16x8 qf[2];
  qf[0] = *(const bf16x8*)(Qs + (16 * w + l15) * 144 + lq * 16);
  qf[1] = *(const bf16x8*)(Qs + (16 * w + l15) * 144 + 64 + lq * 16);
  f32x4 acc[8];
  const u16* SPT = (const u16*)(p.ws + WS_SPT) + (size_t)item * 8192;
#pragma unroll
  for (int et = 0; et < 8; et++) {
    acc[et] = (f32x4){0.f, 0.f, 0.f, 0.f};
#pragma unroll
    for (int ks = 0; ks < 2; ks++) {
      bf16x8 sf = *(const bf16x8*)(SPT + (et * 16 + l15) * 64 + ks * 32 + lq * 8);
      acc[et] = mfma16(sf, qf[ks], acc[et]);
    }
  }
  const float qd = exp2f((float)(16 * w + l15 + 1) * l2g);
#pragma unroll
  for (int et = 0; et < 8; et++)
#pragma unroll
    for (int jj = 0; jj < 4; jj++) acc[et][jj] *= qd;
  for (int mt = 0; mt <= w; mt++) {
    f32x4 sa = (f32x4){0.f, 0.f, 0.f, 0.f};
#pragma unroll
    for (int ks = 0; ks < 2; ks++) {
      bf16x8 kf = *(const bf16x8*)(Ks + (mt * 16 + l15) * 144 + ks * 64 + lq * 16);
      sa = mfma16(qf[ks], kf, sa);
    }
    const int m = mt * 16 + l15;
#pragma unroll
    for (int jj = 0; jj < 4; jj++) {
      const int n = 16 * w + lq * 4 + jj;
      float v = (n >= m) ? sa[jj] * 0.125f * exp2f((float)(n - m) * l2g) : 0.f;
      *(u16*)(Sw + (lq * 4 + jj) * 272 + m * 2) = f2bf(v);
    }
  }
  if ((w & 1) == 0) *(uint2*)(Sw + (lane >> 2) * 272 + ((w + 1) * 16 + (lane & 3) * 4) * 2) = make_uint2(0u, 0u);
  __builtin_amdgcn_wave_barrier();
  __builtin_amdgcn_fence(__ATOMIC_ACQ_REL, "wavefront");
  for (int ks = 0; ks <= (w >> 1); ks++) {
    bf16x8 sf = *(const bf16x8*)(Sw + l15 * 272 + ks * 64 + lq * 16);
#pragma unroll
    for (int et = 0; et < 8; et++) {
      bf16x8 vf = *(const bf16x8*)(Vt + (et * 16 + l15) * 272 + ks * 64 + lq * 16);
      acc[et] = mfma16(vf, sf, acc[et]);
    }
  }
  u16* mixed = (u16*)(p.ws + WS_B);
  const float* gn = p.in[11] + h * 128;
  float sm_ = 0.f;
#pragma unroll
  for (int et = 0; et < 8; et++) sm_ += acc[et][0] + acc[et][1] + acc[et][2] + acc[et][3];
  sm_ += __shfl_xor(sm_, 16, 64);
  sm_ += __shfl_xor(sm_, 32, 64);
  const float mu = sm_ * (1.f / 128.f);
  float vs = 0.f;
#pragma unroll
  for (int et = 0; et < 8; et++)
#pragma unroll
    for (int jj = 0; jj < 4; jj++) { const float d = acc[et][jj] - mu; vs += d * d; }
  vs += __shfl_xor(vs, 16, 64);
  vs += __shfl_xor(vs, 32, 64);
  const float rs = rsqrtf(vs * (1.f / 128.f) + 1e-6f);
  const size_t row = r0 + 16 * w + l15;
#pragma unroll
  for (int et = 0; et < 8; et++) {
    const int e = et * 16 + lq * 4;
    const float4 gg = *(const float4*)(gn + e);
    const float4 ga = ld_bf4(qkv + row * QW + 1024 + h * 128 + e);
    uint2 o;
    o.x = pack2(siluf(ga.x) * ((acc[et][0] - mu) * rs * gg.x), siluf(ga.y) * ((acc[et][1] - mu) * rs * gg.y));
    o.y = pack2(siluf(ga.z) * ((acc[et][2] - mu) * rs * gg.z), siluf(ga.w) * ((acc[et][3] - mu) * rs * gg.w));
    *(uint2*)(mixed + row * DM + h * 128 + e) = o;
  }
  __syncthreads();
}

struct S5c { float ar, ai; };

DEVI void s5_setup(const Params& p, int g, int n, float& ar, float& ai, float* bfr, float* bfi) {
  const float dt = expf(p.in[15][g]);
  const float lr = p.in[13][g * 64 + n], li = p.in[14][g * 64 + n];
  const float mag = expf(lr * dt);
  float sn, cs;
  sincosf(li * dt, &sn, &cs);
  ar = mag * cs; ai = mag * sn;
  const float den = lr * lr + li * li;
  const float fr = ((ar - 1.f) * lr + ai * li) / den;
  const float fi = (ai * lr - (ar - 1.f) * li) / den;
  const float4* br = (const float4*)(p.in[16] + ((size_t)g * 64 + n) * 16);
  const float4* bi = (const float4*)(p.in[17] + ((size_t)g * 64 + n) * 16);
#pragma unroll
  for (int q = 0; q < 4; q++) {
    float4 x = br[q], y = bi[q];
    bfr[q * 4 + 0] = fr * x.x - fi * y.x; bfi[q * 4 + 0] = fr * y.x + fi * x.x;
    bfr[q * 4 + 1] = fr * x.y - fi * y.y; bfi[q * 4 + 1] = fr * y.y + fi * x.y;
    bfr[q * 4 + 2] = fr * x.z - fi * y.z; bfi[q * 4 + 2] = fr * y.z + fi * x.z;
    bfr[q * 4 + 3] = fr * x.w - fi * y.w; bfi[q * 4 + 3] = fr * y.w + fi * x.w;
  }
}

DEVI void s5_stage_u(const Params& p, size_t row0, int L, int go, float* us) {
  const int tid = threadIdx.x;
  const u64* ssq = (const u64*)(p.ws + WS_SSQ);
  const float* gain = p.in[7] + 1024 + go * 128;
  for (int i = tid; i < L * 32; i += NTHR) {
    int t = i >> 5, c4 = i & 31;
    float rstd = ssq_rstd(ssq + TT + row0 + t);
    float4 y = ld_bf4((const u16*)(p.ws + WS_YB) + (row0 + t) * DM + go * 128 + c4 * 4);
    float4 gg = *(const float4*)(gain + c4 * 4);
    *(float4*)(us + t * 128 + c4 * 4) = make_float4(y.x * rstd * gg.x, y.y * rstd * gg.y, y.z * rstd * gg.z, y.w * rstd * gg.w);
  }
}

DEVI void s5c_item(const Params& p, bool sample, int item, char* smem) {
  const int tid = threadIdx.x, lane = tid & 63, n = lane, w = tid >> 6, l15 = lane & 15, lq = lane >> 4;
  int go, L; size_t row0; int b = 0, c = 0, bs = 0;
  if (sample) { go = item & 7; bs = item >> 3; L = 8; row0 = (size_t)TP + bs * 8; }
  else { go = item & 7; c = (item >> 3) & 255; b = item >> 11; L = 32; row0 = (size_t)b * 8192 + c * 32; }
  const int g = go * 8 + w;
  float* us = (float*)smem;
  char* xs = smem + 16384 + w * 8704;
  s5_stage_u(p, row0, L, go, us);
  float ar, ai, bfr[16], bfi[16];
  s5_setup(p, g, n, ar, ai, bfr, bfi);
  float xr, xi;
  if (sample) {
    xr = p.in[5][((size_t)bs * 64 + g) * 64 + n];
    xi = p.in[6][((size_t)bs * 64 + g) * 64 + n];
  } else {
    float2 x0 = ((const float2*)(p.ws + WS_XP))[((size_t)(b * 256 + c) * 64 + g) * 64 + n];
    xr = x0.x; xi = x0.y;
  }
  bf16x8 cf[4];
#pragma unroll
  for (int ks = 0; ks < 4; ks++) {
    const int nb = (ks & 1) * 32 + lq * 8;
    const float* src = ((ks < 2) ? p.in[18] : p.in[19]) + ((size_t)g * 16 + l15) * 64 + nb;
    const float sgn = (ks < 2) ? 1.f : -1.f;
    float4 a0 = *(const float4*)src, a1 = *(const float4*)(src + 4);
    bf16x8 f;
    f[0] = (short)f2bf(sgn * a0.x); f[1] = (short)f2bf(sgn * a0.y); f[2] = (short)f2bf(sgn * a0.z); f[3] = (short)f2bf(sgn * a0.w);
    f[4] = (short)f2bf(sgn * a1.x); f[5] = (short)f2bf(sgn * a1.y); f[6] = (short)f2bf(sgn * a1.z); f[7] = (short)f2bf(sgn * a1.w);
    cf[ks] = f;
  }
  __syncthreads();
  for (int t = 0; t < L; t++) {
    const float4* u4 = (const float4*)(us + t * 128 + w * 16);
    float dr = 0.f, di = 0.f;
#pragma unroll
    for (int q = 0; q < 4; q++) {
      float4 u = u4[q];
      dr += bfr[q * 4] * u.x + bfr[q * 4 + 1] * u.y + bfr[q * 4 + 2] * u.z + bfr[q * 4 + 3] * u.w;
      di += bfi[q * 4] * u.x + bfi[q * 4 + 1] * u.y + bfi[q * 4 + 2] * u.z + bfi[q * 4 + 3] * u.w;
    }
    float nr = ar * xr - ai * xi + dr;
    float ni = ar * xi + ai * xr + di;
    xr = nr; xi = ni;
    *(u16*)(xs + t * 272 + n * 2) = f2bf(xr);
    *(u16*)(xs + t * 272 + 128 + n * 2) = f2bf(xi);
  }
  if (sample) {
    p.out[O_SRS + ((size_t)bs * 64 + g) * 64 + n] = xr;
    p.out[O_SIS + ((size_t)bs * 64 + g) * 64 + n] = xi;
    for (int t = 8; t < 16; t++) { *(u16*)(xs + t * 272 + n * 2) = 0; *(u16*)(xs + t * 272 + 128 + n * 2) = 0; }
  }
  __builtin_amdgcn_wave_barrier();
  __builtin_amdgcn_fence(__ATOMIC_ACQ_REL, "wavefront");
  u16* z = (u16*)(p.ws + WS_B);
  const float dsk = p.in[20][g * 16 + l15];
  const int nmt = sample ? 1 : 2;
  for (int mt = 0; mt < nmt; mt++) {
    f32x4 ya = (f32x4){0.f, 0.f, 0.f, 0.f};
#pragma unroll
    for (int ks = 0; ks < 4; ks++) {
      bf16x8 xf = *(const bf16x8*)(xs + (mt * 16 + l15) * 272 + ks * 64 + lq * 16);
      ya = mfma16(xf, cf[ks], ya);
    }
#pragma unroll
    for (int jj = 0; jj < 4; jj++) {
      const int t = mt * 16 + lq * 4 + jj;
      if (t < L) {
        float y = ya[jj] + dsk * us[t * 128 + w * 16 + l15];
        z[(row0 + t) * DM + g * 16 + l15] = f2bf(geluf(y));
      }
    }
  }
  __syncthreads();
}

DEVI void s5_pre_item(const Params& p, int item, char* smem) {
  const int tid = threadIdx.x, g = item >> 2, tq = item & 3;
  float2* bfs = (float2*)smem;
  float2* apw = bfs + 1024;
  float2* cs = apw + 33 * 64;
  if (tid < 64) {
    float ar, ai, bfr[16], bfi[16];
    s5_setup(p, g, tid, ar, ai, bfr, bfi);
    const float* gain = p.in[7] + 1024 + g * 16;
#pragma unroll
    for (int q = 0; q < 16; q++) bfs[tid * 16 + q] = make_float2(bfr[q] * gain[q], bfi[q] * gain[q]);
    float pr = 1.f, pi = 0.f;
    for (int d = 0; d <= 32; d++) {
      apw[d * 64 + tid] = make_float2(pr, pi);
      float nr = pr * ar - pi * ai, ni = pr * ai + pi * ar;
      pr = nr; pi = ni;
    }
  }
  for (int i = tid; i < 1024; i += NTHR) cs[i] = make_float2(p.in[18][(size_t)g * 1024 + i], p.in[19][(size_t)g * 1024 + i]);
  __syncthreads();
  u16* KD = (u16*)(p.ws + WS_KD) + (size_t)g * 32 * 256;
#pragma unroll 1
  for (int i = 0; i < 4; i++) {
    const int o = tid + 512 * i, dl = o >> 8, pp = (o >> 4) & 15, q = o & 15, d = 8 * tq + dl;
    float acc = 0.f;
#pragma unroll 4
    for (int n = 0; n < 64; n++) {
      float2 c = cs[pp * 64 + n], a = apw[d * 64 + n], bb = bfs[n * 16 + q];
      float car = c.x * a.x - c.y * a.y, cai = c.x * a.y + c.y * a.x;
      acc += car * bb.x - cai * bb.y;
    }
    if (d == 0 && pp == q) acc += p.in[20][g * 16 + pp] * p.in[7][1024 + g * 16 + pp];
    KD[d * 256 + pp * 16 + q] = f2bf(acc);
  }
  u16* MT = (u16*)(p.ws + WS_MT) + (size_t)g * 128 * 512;
#pragma unroll 4
  for (int i = 0; i < 32; i++) {
    const int o = tid + 512 * i, np = o >> 7, kk = o & 127, sl = kk >> 4, q = kk & 15, sI = 8 * tq + sl, n = np & 63;
    float2 a = apw[(31 - sI) * 64 + n], bb = bfs[n * 16 + q];
    float v = (np < 64) ? (a.x * bb.x - a.y * bb.y) : (a.x * bb.y + a.y * bb.x);
    MT[np * 512 + sI * 16 + q] = f2bf(v);
  }
  u16* PT = (u16*)(p.ws + WS_PT) + (size_t)g * 512 * 128;
#pragma unroll 4
  for (int i = 0; i < 32; i++) {
    const int o = tid + 512 * i, tpl = o >> 7, np = o & 127, tl = tpl >> 4, pp = tpl & 15, t = 8 * tq + tl, n = np & 63;
    float2 c = cs[pp * 64 + n], a = apw[(t + 1) * 64 + n];
    float v = (np < 64) ? (c.x * a.x - c.y * a.y) : -(c.x * a.y + c.y * a.x);
    PT[(t * 16 + pp) * 128 + np] = f2bf(v);
  }
  __syncthreads();
}

DEVI bf16x8 s5_ufrag(const u16* yb, const u64* ssq1, int row, int col) {
  uint4 raw = *(const uint4*)(yb + (size_t)row * DM + col);
  const float rs = ssq_rstd(ssq1 + row);
  const unsigned r0 = raw.x, r1 = raw.y, r2 = raw.z, r3 = raw.w;
  const u32x4 o = {pack2(__uint_as_float(r0 << 16) * rs, __uint_as_float(r0 & 0xffff0000u) * rs),
                   pack2(__uint_as_float(r1 << 16) * rs, __uint_as_float(r1 & 0xffff0000u) * rs),
                   pack2(__uint_as_float(r2 << 16) * rs, __uint_as_float(r2 & 0xffff0000u) * rs),
                   pack2(__uint_as_float(r3 << 16) * rs, __uint_as_float(r3 & 0xffff0000u) * rs)};
  return __builtin_bit_cast(bf16x8, o);
}

DEVI void s5a_mfma(const Params& p, int g, int mtq, char* smem) {
  int tid_ = threadIdx.x; asm volatile("" : "+v"(tid_));
  const int tid = tid_, lane = tid & 63, w = tid >> 6, fr = lane & 15, fq = lane >> 4;
  const int c0 = (mtq * 8 + w) * 16;
  const u16* yb = (const u16*)(p.ws + WS_YB);
  const u64* ssq1 = (const u64*)(p.ws + WS_SSQ) + TT;
  const u16* MT = (const u16*)(p.ws + WS_MT) + (size_t)g * 128 * 512;
  bf16x8 au[16];
#pragma unroll
  for (int ks = 0; ks < 16; ks++) au[ks] = s5_ufrag(yb, ssq1, (c0 + fr) * 32 + 2 * ks + (fq >> 1), g * 16 + (fq & 1) * 8);
  f32x4 acc[8];
#pragma unroll
  for (int n = 0; n < 8; n++) acc[n] = (f32x4){0.f, 0.f, 0.f, 0.f};
  u32x4 stg[8];
#pragma unroll
  for (int i = 0; i < 8; i++) { const int ch = tid + i * 512, r = ch >> 5, cc = ch & 31; stg[i] = *(const u32x4*)(MT + (size_t)r * 512 + cc * 8); }
#pragma unroll
  for (int half = 0; half < 2; half++) {
    __syncthreads();
#pragma unroll
    for (int i = 0; i < 8; i++) {
      const int ch = tid + i * 512, r = ch >> 5, cc = ch & 31;
      *(u32x4*)(smem + r * 528 + cc * 16) = stg[i];
    }
    __syncthreads();
    if (half == 0) {
#pragma unroll
      for (int i = 0; i < 8; i++) { const int ch = tid + i * 512, r = ch >> 5, cc = ch & 31; stg[i] = *(const u32x4*)(MT + (size_t)r * 512 + 256 + cc * 8); }
    }
#pragma unroll
    for (int ksl = 0; ksl < 8; ksl++) {
#pragma unroll
      for (int n = 0; n < 8; n++) {
        bf16x8 bf = *(const bf16x8*)(smem + (n * 16 + fr) * 528 + ksl * 64 + fq * 16);
        acc[n] = mfma16(bf, au[half * 8 + ksl], acc[n]);
      }
    }
  }
  float* E = (float*)(p.ws + WS_E) + ((size_t)(c0 + fr) * 64 + g) * 128;
#pragma unroll
  for (int n = 0; n < 8; n++) *(float4*)(E + n * 16 + fq * 4) = make_float4(acc[n][0], acc[n][1], acc[n][2], acc[n][3]);
  __syncthreads();
}

DEVI void s5c_mfma(const Params& p, int g, int mtq, char* smem) {
  const int tid = threadIdx.x, lane = tid & 63, w = tid >> 6, fr = lane & 15, fq = lane >> 4;
  const int c0 = (mtq * 8 + w) * 16;
  const u16* yb = (const u16*)(p.ws + WS_YB);
  const u64* ssq1 = (const u64*)(p.ws + WS_SSQ) + TT;
  const u16* KDg = (const u16*)(p.ws + WS_KD) + (size_t)g * 32 * 256;
  const u16* PTg = (const u16*)(p.ws + WS_PT) + (size_t)g * 512 * 128;
  const u16* XP = (const u16*)(p.ws + WS_XP) + ((size_t)(c0 + fr) * 64 + g) * 128;
  u16* z = (u16*)(p.ws + WS_B);
  char* KDs = smem;
  char* PTs = smem + 16384;
#pragma unroll
  for (int i = 0; i < 2; i++) { const int ch = tid + i * 512; *(uint4*)(KDs + ch * 16) = *(const uint4*)(KDg + ch * 8); }
  bf16x8 au[16], ax[4];
#pragma unroll
  for (int ks = 0; ks < 16; ks++) au[ks] = s5_ufrag(yb, ssq1, (c0 + fr) * 32 + 2 * ks + (fq >> 1), g * 16 + (fq & 1) * 8);
#pragma unroll
  for (int ks = 0; ks < 4; ks++) ax[ks] = *(const bf16x8*)(XP + ks * 32 + fq * 8);
  const bf16x8 zero8 = (bf16x8){0, 0, 0, 0, 0, 0, 0, 0};
  u32x4 stg[8];
#pragma unroll
  for (int i = 0; i < 8; i++) { const int ch = tid + i * 512, r = ch >> 4, cc = ch & 15; stg[i] = *(const u32x4*)(PTg + (size_t)r * 128 + cc * 8); }
#pragma unroll
  for (int half = 0; half < 2; half++) {
    __syncthreads();
#pragma unroll
    for (int i = 0; i < 8; i++) {
      const int ch = tid + i * 512, r = ch >> 4, cc = ch & 15;
      *(u32x4*)(PTs + r * 272 + cc * 16) = stg[i];
    }
    __syncthreads();
    if (half == 0) {
#pragma unroll
      for (int i = 0; i < 8; i++) { const int ch = tid + i * 512, r = ch >> 4, cc = ch & 15; stg[i] = *(const u32x4*)(PTg + (size_t)(256 + r) * 128 + cc * 8); }
    }
#pragma unroll 1
    for (int q4 = 0; q4 < 4; q4++) {
      const int t0 = half * 16 + q4 * 4;
      const int nks = (t0 >> 1) + 2;
      f32x4 acc[4];
#pragma unroll
      for (int j = 0; j < 4; j++) acc[j] = (f32x4){0.f, 0.f, 0.f, 0.f};
#pragma unroll
      for (int ks = 0; ks < 16; ks++) {
        if (ks < nks) {
#pragma unroll
          for (int j = 0; j < 4; j++) {
            const int d = t0 + j - 2 * ks - (fq >> 1);
            const int dc = d < 0 ? 0 : d;
            bf16x8 bf = *(const bf16x8*)(KDs + (dc * 256 + fr * 16 + (fq & 1) * 8) * 2);
            bf = (d < 0) ? zero8 : bf;
            acc[j] = mfma16(bf, au[ks], acc[j]);
          }
        }
      }
#pragma unroll
      for (int ks = 0; ks < 4; ks++) {
#pragma unroll
        for (int j = 0; j < 4; j++) {
          bf16x8 bf = *(const bf16x8*)(PTs + ((q4 * 4 + j) * 16 + fr) * 272 + ks * 64 + fq * 16);
          acc[j] = mfma16(bf, ax[ks], acc[j]);
        }
      }
#pragma unroll
      for (int j = 0; j < 4; j++) {
        const int row = (c0 + fr) * 32 + t0 + j, col = g * 16 + fq * 4;
        uint2 o; o.x = pack2(geluf(acc[j][0]), geluf(acc[j][1])); o.y = pack2(geluf(acc[j][2]), geluf(acc[j][3]));
        *(uint2*)(z + (size_t)row * DM + col) = o;
      }
    }
  }
  __syncthreads();
}

DEVI void s5b_item(const Params& p, int item, char* smem) {
  const int tid = threadIdx.x, n = tid & 63, seg = tid >> 6;
  const int b = item >> 6, g = item & 63;
  float2* cs_ = (float2*)smem;
  const float dt = expf(p.in[15][g]);
  const float lr = p.in[13][g * 64 + n], li = p.in[14][g * 64 + n];
  const float mag = expf(lr * dt);
  float sn, cs;
  sincosf(li * dt, &sn, &cs);
  float ar = mag * cs, ai = mag * sn;
#pragma unroll
  for (int q = 0; q < 5; q++) { float r2 = ar * ar - ai * ai, i2 = 2.f * ar * ai; ar = r2; ai = i2; }
  const float* E = (const float*)(p.ws + WS_E) + (((size_t)b * 256 + seg * 32) * 64 + g) * 128 + n;
  u16* XP = (u16*)(p.ws + WS_XP) + (((size_t)b * 256 + seg * 32) * 64 + g) * 128 + n;
  float er[32], ei[32];
#pragma unroll
  for (int c = 0; c < 32; c++) { er[c] = E[(size_t)c * 8192]; ei[c] = E[(size_t)c * 8192 + 64]; }
  float xr = 0.f, xi = 0.f;
#pragma unroll
  for (int c = 0; c < 32; c++) {
    float nr = ar * xr - ai * xi + er[c], ni = ar * xi + ai * xr + ei[c];
    xr = nr; xi = ni;
  }
  cs_[seg * 64 + n] = make_float2(xr, xi);
  __syncthreads();
  if (tid < 64) {
    float sr = ar, si = ai;
#pragma unroll
    for (int q = 0; q < 5; q++) { float r2 = sr * sr - si * si, i2 = 2.f * sr * si; sr = r2; si = i2; }
    float cr = 0.f, ci = 0.f;
    for (int sg = 0; sg < 8; sg++) {
      float2 e = cs_[sg * 64 + n];
      cs_[sg * 64 + n] = make_float2(cr, ci);
      float nr = sr * cr - si * ci + e.x, ni = sr * ci + si * cr + e.y;
      cr = nr; ci = ni;
    }
    p.out[O_SRP + (size_t)b * 4096 + g * 64 + n] = cr;
    p.out[O_SIP + (size_t)b * 4096 + g * 64 + n] = ci;
  }
  __syncthreads();
  float2 c0 = cs_[seg * 64 + n];
  xr = c0.x; xi = c0.y;
#pragma unroll
  for (int c = 0; c < 32; c++) {
    XP[(size_t)c * 8192] = f2bf(xr);
    XP[(size_t)c * 8192 + 64] = f2bf(xi);
    float nr = ar * xr - ai * xi + er[c], ni = ar * xi + ai * xr + ei[c];
    xr = nr; xi = ni;
  }
  __syncthreads();
}

DEVI void phase_final(const Params& p) {
  const int lane = threadIdx.x & 63, wid = threadIdx.x >> 6;
  const u64* ssq = (const u64*)(p.ws + WS_SSQ);
  const u16* yb = (const u16*)(p.ws + WS_YB);
  const float* g = p.in[9];
  float4 gg[4];
#pragma unroll
  for (int i = 0; i < 4; i++) gg[i] = *(const float4*)(g + i * 256 + lane * 4);
  const int nw = gridDim.x * 8;
  for (int row = blockIdx.x * 8 + wid; row < TT; row += nw * 4) {
    float4 v[4][4]; float rstd[4];
#pragma unroll
    for (int r = 0; r < 4; r++) {
      const int rr = row + r * nw;
      if (rr < TT) {
        rstd[r] = ssq_rstd(ssq + 3 * TT + rr);
#pragma unroll
        for (int i = 0; i < 4; i++) v[r][i] = ld_bf4(yb + (size_t)rr * DM + i * 256 + lane * 4);
      }
    }
#pragma unroll
    for (int r = 0; r < 4; r++) {
      const int rr = row + r * nw;
      if (rr < TT) {
        float* y = p.out + (size_t)rr * DM;
#pragma unroll
        for (int i = 0; i < 4; i++)
          *(float4*)(y + i * 256 + lane * 4) = make_float4(v[r][i].x * rstd[r] * gg[i].x, v[r][i].y * rstd[r] * gg[i].y, v[r][i].z * rstd[r] * gg[i].z, v[r][i].w * rstd[r] * gg[i].w);
      }
    }
  }
}

DEVI void copy_tail(const Params& p, int r0, int r1) {
  const int fb = (gridDim.x == 256) ? 128 : 0, nbk = (int)gridDim.x - fb, lb = (int)blockIdx.x - fb;
  if (lb < 0) return;
#pragma unroll 1
  for (int R0 = r0 + lb; R0 < r1; R0 += nbk * 8) {
    f32x4 v[8];
#pragma unroll
    for (int k = 0; k < 8; k++) {
      const int R = R0 + k * nbk;
      if (R < r1) { int kv; const size_t o = cp_off(R, kv); v[k] = __builtin_nontemporal_load((const f32x4*)p.in[3 + kv] + 8 * 512 / 4 + o); }
    }
#pragma unroll
    for (int k = 0; k < 8; k++) {
      const int R = R0 + k * nbk;
      if (R < r1) { int kv; const size_t o = cp_off(R, kv); __builtin_nontemporal_store(v[k], (f32x4*)(p.out + (kv ? O_VS : O_KS)) + o); }
    }
  }
}

DEVI void ffn_block(const Params& p, int layer, const XcdBarrier& xb, char* smem) {
  u16* bufA = (u16*)(p.ws + WS_A);
  u16* yb = (u16*)(p.ws + WS_YB);
  u64* ssq = (u64*)(p.ws + WS_SSQ);
  {
    SEpiSwiglu ES{bufA, ssq + (layer ? 2 * TT : 0)};
    sample_gemm(smem, yb, (const u16*)(p.ws + WS_WF1 + layer * SZ_WF1), 1024, 88, true, ES);
    EpiSwiglu E{bufA, ssq + (layer ? 2 * TT : 0)};
    run_gemm(smem, yb, (const u16*)(p.ws + WS_WF1 + layer * SZ_WF1), 5632, 1024, E);
    copy_tail(p, layer * CP_TAIL, (layer + 1) * CP_TAIL);
  }
  xcd_barrier(xb);
  {
    SEpiRes ES{yb, ssq + (layer ? 3 * TT : TT), nullptr};
    sample_gemm(smem, bufA, (const u16*)(p.ws + WS_WF2 + layer * SZ_WF2), 2816, 16, false, ES);
    EpiRes E{yb, ssq + (layer ? 3 * TT : TT), nullptr, nullptr};
    run_gemm(smem, bufA, (const u16*)(p.ws + WS_WF2 + layer * SZ_WF2), 1024, 2816, E);
  }
  xcd_barrier(xb);
}

__global__ void __launch_bounds__(NTHR, 2) mega(Params p) {
  extern __shared__ __attribute__((aligned(16))) char smem[];
  cg::grid_group grid = cg::this_grid();
  volatile LAS3 unsigned* xst = (volatile LAS3 unsigned*)(LAS3 char*)(smem + 128 * 1024);
  if (threadIdx.x == 0) { xst[0] = 0u; xst[1] = 0u; }
  __syncthreads();
  const XcdBarrier xb = xcd_barrier_post((unsigned*)(p.ws + WS_BAR), xst);
  u16* bufA = (u16*)(p.ws + WS_A);
  u16* bufB = (u16*)(p.ws + WS_B);
  u16* yb = (u16*)(p.ws + WS_YB);
  u64* ssq = (u64*)(p.ws + WS_SSQ);

  phase_prep(p, smem);
  for (int it = blockIdx.x; it < 256; it += gridDim.x) s5_pre_item(p, it, smem);
  xcd_barrier(xb);
  {
    SEpiQKV ES{bufA, p.out};
    sample_gemm(smem, bufB, (const u16*)(p.ws + WS_WIN), 1024, 48, false, ES);
    EpiQKV E{bufA, p.out};
    run_gemm(smem, bufB, (const u16*)(p.ws + WS_WIN), 3072, 1024, E);
  }
  xcd_barrier(xb);
  phase_mix_a(p, smem);
  xcd_barrier(xb);
  phase_mix_b(p);
  for (int it = (blockIdx.x + gridDim.x / 2) % gridDim.x; it < 128; it += gridDim.x) ret_sample_item(p, it, smem);
  xcd_barrier(xb);
  {
    RoRegs R;
    if ((int)blockIdx.x < 512) ro_load(p, blockIdx.x, R);
    for (int it = blockIdx.x; it < 512; it += gridDim.x) {
      const int nx = it + (int)gridDim.x;
      ret_out_item(p, it, smem, R, nx < 512 ? nx : -1);
    }
  }
  xcd_barrier(xb);
  {
    SEpiRes ES{yb, ssq, p.in[1]};
    sample_gemm(smem, bufB, (const u16*)(p.ws + WS_WOUT), 1024, 16, false, ES);
    EpiRes E{yb, ssq, p.in[0], p.in[1]};
    run_gemm(smem, bufB, (const u16*)(p.ws + WS_WOUT), 1024, 1024, E);
  }
  xcd_barrier(xb);
  ffn_block(p, 0, xb, smem);
  for (int it = blockIdx.x; it < 256; it += gridDim.x) {
    const int g = (it & 7) * 8 + (it >> 5), mtq = (it >> 3) & 3;
    s5a_mfma(p, g, mtq, smem);
  }
  xcd_barrier(xb);
  for (int it = blockIdx.x; it < 128; it += gridDim.x) s5b_item(p, it, smem);
  for (int it = (blockIdx.x + 128) % gridDim.x; it < 256; it += gridDim.x) s5c_item(p, true, it, smem);
  xcd_barrier(xb);
  for (int it = blockIdx.x; it < 256; it += gridDim.x) {
    const int g = (it & 7) * 8 + (it >> 5), mtq = (it >> 3) & 3;
    s5c_mfma(p, g, mtq, smem);
  }
  xcd_barrier(xb);
  {
    SEpiGlu ES{yb, ssq + 2 * TT};
    sample_gemm(smem, bufB, (const u16*)(p.ws + WS_WGLU), 1024, 32, true, ES);
    EpiGlu E{yb, ssq + 2 * TT};
    run_gemm(smem, bufB, (const u16*)(p.ws + WS_WGLU), 2048, 1024, E);
  }
  xcd_barrier(xb);
  ffn_block(p, 1, xb, smem);
  phase_final(p);
  if (p.ws == nullptr) grid.sync();
}

extern "C" void kernel_launch(void* const* d_in, const int* in_sizes, int n_in,
                              void* d_out, int out_size, void* d_ws, size_t ws_size,
                              hipStream_t stream) {
  static int grid_blocks = 0;
  if (!grid_blocks) {
    int dev = 0, cus = 0, per_cu = 0;
    (void)hipGetDevice(&dev);
    (void)hipDeviceGetAttribute(&cus, hipDeviceAttributeMultiprocessorCount, dev);
    (void)hipFuncSetAttribute((const void*)mega, hipFuncAttributeMaxDynamicSharedMemorySize, LDS_BYTES);
    (void)hipOccupancyMaxActiveBlocksPerMultiprocessor(&per_cu, mega, NTHR, LDS_BYTES);
    if (per_cu < 1) per_cu = 1;
    if (per_cu > 1) per_cu = 1;
    grid_blocks = cus * per_cu;
  }
  Params p{};
  for (int i = 0; i < 24; i++) p.in[i] = (const float*)d_in[i];
  p.out = (float*)d_out;
  p.ws = (char*)d_ws;
  (void)hipMemsetAsync((char*)d_ws + WS_BAR, 0, XCD_BAR_WORDS * 4, stream);
  void* args[] = {&p};
  hipError_t e = hipLaunchCooperativeKernel((void*)mega, dim3(grid_blocks), dim3(NTHR), args, LDS_BYTES, stream);
  if (e != hipSuccess) fprintf(stderr, "coop launch failed: %s (grid %d)\n", hipGetErrorString(e), grid_blocks);
}
```
